# Optimizing an MI355X kernel written in HIP

```python
import jax, jax.numpy as jnp
from jax import lax
import numpy as np

D_MODEL = 2048
BATCH = 4
SEQ = 2048
DEPTH = 1

CHUNK = 64
HGRN_WIDTH = D_MODEL // 2
HGRN_HEAD_DIM = 128
HGRN_HEADS = HGRN_WIDTH // HGRN_HEAD_DIM
GMLP_WIDTH = D_MODEL // 2
GMLP_CHUNK = 128
GMLP_HEADS = 8
GMLP_HEAD_DIM = GMLP_WIDTH // GMLP_HEADS
D_FF = 4 * D_MODEL
PLE_DIM = 256
EPS = 1e-6

kernel_name = "hybrid_hgrn2_gmlp_gated_block"


def rmsnorm(x, g):
    xf = x.astype(jnp.float32)
    y = xf * lax.rsqrt(jnp.mean(xf * xf, axis=-1, keepdims=True) + EPS)
    return (y * g.astype(jnp.float32)).astype(x.dtype)


def layernorm(x, g, b):
    xf = x.astype(jnp.float32)
    mu = jnp.mean(xf, axis=-1, keepdims=True)
    var = jnp.mean(jnp.square(xf - mu), axis=-1, keepdims=True)
    y = (xf - mu) * lax.rsqrt(var + EPS)
    return (y * g.astype(jnp.float32) + b.astype(jnp.float32)).astype(x.dtype)


def hgrn2_scan(q, k, v, logf):
    B, S, H, d = q.shape
    nC = S // CHUNK

    def to_chunks(a):
        return a.reshape(B, nC, CHUNK, H, d).transpose(1, 0, 3, 2, 4)

    xs = (to_chunks(q), to_chunks(k), to_chunks(v), to_chunks(logf))
    causal = jnp.tril(jnp.ones((CHUNK, CHUNK), dtype=bool))[None, None, :, :, None]

    def step(state, inp):
        qc, kc, vc, gc = inp
        b = jnp.cumsum(gc, axis=2)
        inter = jnp.einsum('bhtd,bhde->bhte', qc * jnp.exp(b), state)
        diff = b[:, :, :, None, :] - b[:, :, None, :, :]
        decay = jnp.exp(jnp.where(causal, diff, -jnp.inf))
        attn = jnp.einsum('bhtd,bhsd,bhtsd->bhts', qc, kc, decay)
        intra = jnp.einsum('bhts,bhse->bhte', attn, vc)
        b_last = b[:, :, -1:, :]
        new_state = (jnp.exp(b_last[:, :, 0, :])[..., None] * state
                     + jnp.einsum('bhsd,bhse->bhde', kc * jnp.exp(b_last - b), vc))
        return new_state, inter + intra

    state0 = jnp.zeros((B, H, d, d), jnp.float32)
    _, out = lax.scan(step, state0, xs)
    return out.transpose(1, 0, 3, 2, 4).reshape(B, S, H, d)


def gmlp_spatial(v, w_s, b_s):
    B, S, _ = v.shape
    nG = S // GMLP_CHUNK
    pos = jnp.arange(GMLP_CHUNK)
    mask = (pos[None, :] // CHUNK) <= (pos[:, None] // CHUNK)
    w_eff = jnp.where(mask[None], w_s, jnp.zeros_like(w_s))
    vg = v.reshape(B, nG, GMLP_CHUNK, GMLP_HEADS, GMLP_HEAD_DIM)
    sv = jnp.einsum('hts,bgshc->bgthc', w_eff, vg) + b_s.T[:, :, None]
    return sv.reshape(B, S, GMLP_WIDTH)


def setup_inputs(seed: int = 0) -> dict:
    key = jax.random.key(seed)
    ks = jax.random.split(key, 24)
    f32 = jnp.float32
    n_in = 4 * HGRN_WIDTH + 2 * GMLP_WIDTH + 2 * D_MODEL

    def nrm(k, shape, fan_in):
        return jax.random.normal(k, shape, f32) * (fan_in ** -0.5)

    def gain(k, shape):
        return 1.0 + 0.02 * jax.random.normal(k, shape, f32)

    return {
        "x": jax.random.normal(ks[0], (BATCH, SEQ, D_MODEL), f32),
        "p": jax.random.normal(ks[1], (DEPTH, BATCH, SEQ, PLE_DIM), f32),
        "norm_mix": gain(ks[2], (DEPTH, D_MODEL)),
        "w_in": nrm(ks[3], (DEPTH, D_MODEL, n_in), D_MODEL),
        "lb_logits": 0.1 * jax.random.normal(ks[4], (DEPTH + 1, HGRN_WIDTH), f32),
        "hgrn_norm": gain(ks[5], (DEPTH, HGRN_HEAD_DIM)),
        "w_a_out": nrm(ks[6], (DEPTH, HGRN_WIDTH, D_MODEL), HGRN_WIDTH),
        "gmlp_ln_g": gain(ks[7], (DEPTH, GMLP_WIDTH)),
        "gmlp_ln_b": 0.02 * jax.random.normal(ks[8], (DEPTH, GMLP_WIDTH), f32),
        "w_spatial": nrm(ks[9], (DEPTH, GMLP_HEADS, GMLP_CHUNK, GMLP_CHUNK), GMLP_CHUNK),
        "b_spatial": gain(ks[10], (DEPTH, GMLP_HEADS, GMLP_CHUNK)),
        "w_b_out": nrm(ks[11], (DEPTH, GMLP_WIDTH, D_MODEL), GMLP_WIDTH),
        "w_o": nrm(ks[12], (DEPTH, D_MODEL, D_MODEL), D_MODEL),
        "norm_ffn": gain(ks[13], (DEPTH, D_MODEL)),
        "w_ff1": nrm(ks[14], (DEPTH, D_MODEL, D_FF), D_MODEL),
        "w_ff2": nrm(ks[15], (DEPTH, D_FF, D_MODEL), D_FF),
        "norm_ple": gain(ks[16], (DEPTH, D_MODEL)),
        "w_ple_gate": nrm(ks[17], (DEPTH, D_MODEL, D_MODEL), D_MODEL),
        "w_ple_proj": nrm(ks[18], (DEPTH, PLE_DIM, D_MODEL), PLE_DIM),
        "norm_final": gain(ks[19], (D_MODEL,)),
    }


def reference(x, p, norm_mix, w_in, lb_logits, hgrn_norm, w_a_out, gmlp_ln_g, gmlp_ln_b,
              w_spatial, b_spatial, w_b_out, w_o, norm_ffn, w_ff1, w_ff2, norm_ple,
              w_ple_gate, w_ple_proj, norm_final):
    B, S, _ = x.shape
    f32 = jnp.float32
    split_sizes = [HGRN_WIDTH] * 4 + [GMLP_WIDTH] * 2 + [D_MODEL] * 2
    split_idx = [int(s) for s in np.cumsum(split_sizes)[:-1]]
    lower_bounds = jnp.cumsum(jax.nn.softmax(lb_logits.astype(f32), axis=0), axis=0)

    for i in range(DEPTH):
        h = rmsnorm(x, norm_mix[i])
        proj = h @ w_in[i]
        q, f_pre, inp, g, u, v, gate_a, gate_b = jnp.split(proj, split_idx, axis=-1)

        lb = lower_bounds[i]
        f = lb + (1.0 - lb) * jax.nn.sigmoid(f_pre.astype(f32))
        k = 1.0 - f
        heads = lambda a: a.reshape(B, S, HGRN_HEADS, HGRN_HEAD_DIM)
        o = hgrn2_scan(heads(jax.nn.silu(q.astype(f32))), heads(k),
                       heads(inp.astype(f32)), heads(jnp.log(f)))
        o = rmsnorm(o, hgrn_norm[i]).astype(x.dtype) * jax.nn.silu(heads(g))
        y_a = o.reshape(B, S, HGRN_WIDTH) @ w_a_out[i]

        u = jax.nn.gelu(u, approximate=False)
        v = layernorm(jax.nn.gelu(v, approximate=False), gmlp_ln_g[i], gmlp_ln_b[i])
        y_b = (u * gmlp_spatial(v, w_spatial[i], b_spatial[i])) @ w_b_out[i]

        merged = jax.nn.sigmoid(gate_a) * y_a + jax.nn.sigmoid(gate_b) * y_b
        x = x + merged @ w_o[i]

        hf = rmsnorm(x, norm_ffn[i])
        x = x + jnp.square(jax.nn.relu(hf @ w_ff1[i])) @ w_ff2[i]

        gate_p = jax.nn.sigmoid(rmsnorm(x, norm_ple[i]) @ w_ple_gate[i])
        x = x + gate_p * (p[i] @ w_ple_proj[i])

    return rmsnorm(x, norm_final)
```

```cpp
#include <hip/hip_runtime.h>
#include <hip/hip_cooperative_groups.h>
#include <cstdio>
#include <cstdint>
namespace cg = cooperative_groups;
namespace pg8 {
#define PG8_LAS __attribute__((address_space(3)))
typedef unsigned short bf16_t;
typedef short bf16x8 __attribute__((ext_vector_type(8)));
typedef float f32x4 __attribute__((ext_vector_type(4)));
typedef unsigned u32x4 __attribute__((ext_vector_type(4)));
constexpr int BM = 256, BK = 64, HALF = 128, HTB = HALF * BK * 2  , STAGE_BYTES = 8 * HTB, NXCD = 8, WGM = 8;

__host__ __device__ __forceinline__ int lds_byte(int r, int c) { const int st = (r >> 4) * 2 + (c >> 5), rr = r & 15, cc = c & 31, ob = rr * 64 + cc * 2; return st * 1024 + (ob ^ (((ob >> 9) & 1) << 5)); }
__host__ __device__ __forceinline__ void stage_rc(int b, int& R, int& C) { const int st = b / 1024, sb = b % 1024, swz = sb ^ (((sb >> 9) & 1) << 5); R = (st >> 1) * 16 + swz / 64; C = (st & 1) * 32 + (swz % 64) / 2; }
__host__ __device__ __forceinline__ int perm32(int rho) { const int n = rho >> 4, i = rho & 15; return 8 * (i >> 2) + 4 * n + (i & 3); }

struct Unit { int pm, pn; };
struct Gemm { const bf16_t* A; const bf16_t* Bt; int M, N, K; };

struct StaticOrder {
    int nM, nN, nwg, G, c;
    __host__ __device__ void init(int M, int N, int G_, int c_) { nM = M / BM; nN = N / BM; nwg = nM * nN; G = G_; c = c_; }
    __host__ __device__ bool next(int i, Unit& u) const {
        const long L = (long)i * G + c; if (L >= nwg) return false;
        int wgid = (int)L; { const int q = nwg / NXCD, r = nwg % NXCD, xcd = wgid % NXCD, off = wgid / NXCD; wgid = (xcd < r ? xcd * (q + 1) : r * (q + 1) + (xcd - r) * q) + off; }
        const int nig = WGM * nN, gid = wgid / nig, fm = gid * WGM, gsz = (nM - fm) < WGM ? (nM - fm) : WGM;
        u.pm = fm + ((wgid % nig) % gsz); u.pn = (wgid % nig) / gsz; return true;
    }
    __device__ __forceinline__ void a_ready(const Unit&) const {}
    __device__ __forceinline__ void done(const Unit&) const {}
};
__device__ __forceinline__ unsigned cvt_pk_bf16(float lo, float hi) { unsigned r; asm volatile("v_cvt_pk_bf16_f32 %0, %1, %2" : "=v"(r) : "v"(lo), "v"(hi)); return r; }
typedef float f32x2 __attribute__((ext_vector_type(2)));
template <class Epi, class Sched, bool ALIGN_EPI = false, bool SP2 = false>
__device__ __forceinline__ void gemm_phase(PG8_LAS unsigned char* lds, const Gemm g, const Sched& S, const Epi& E) {
    const int tid = threadIdx.x, wid = __builtin_amdgcn_readfirstlane(tid >> 6), lane = tid & 63, wr = wid >> 2, wc = wid & 3, fr = lane & 15, fq = lane >> 4;
    const int K = g.K, nt = K / BK;
    unsigned voffA[2], voffB[2];
#pragma unroll
    for (int i = 0; i < 2; ++i) { int R, C; stage_rc(tid * 16 + i * 8192, R, C); const int Rb = Epi::PERM ? ((R & ~31) + perm32(R & 31)) : R;
        voffA[i] = (unsigned)(R * K + C) * 2u; voffB[i] = (unsigned)(Rb * K + C) * 2u; }
    const size_t kstep = (size_t)(BK * 2);
    const size_t hstep = (size_t)HALF * K * 2;
    const size_t tstep = 2 * hstep;
    const unsigned ldsw = (unsigned)wid * 1024u;
    const int aoff = lds_byte(wr * 64 + fr, fq * 8), boff = lds_byte(wc * 32 + fr, fq * 8);
#define PG8_SA(b, h) (((b) * 2 + (h)) * HTB)
#define PG8_SB(b, h) ((4 + (b) * 2 + (h)) * HTB)
#define PG8_STAGE(bufoff, gbase, voff) do { _Pragma("unroll") for (int _i = 0; _i < 2; ++_i) \
        __builtin_amdgcn_global_load_lds((const unsigned*)((const char*)(gbase) + (voff)[_i]), (PG8_LAS unsigned*)(lds + (bufoff) + ldsw + _i * 8192), 16, 0, 0); } while (0)
#define PG8_LDA(dst, b, h) do { _Pragma("unroll") for (int m = 0; m < 4; ++m) _Pragma("unroll") for (int k = 0; k < 2; ++k) dst[m][k] = *(const PG8_LAS bf16x8*)(lds + PG8_SA(b, h) + aoff + m * 2048 + k * 1024); } while (0)
#define PG8_LDB(dst, b, h) do { _Pragma("unroll") for (int n = 0; n < 2; ++n) _Pragma("unroll") for (int k = 0; k < 2; ++k) dst[n][k] = *(const PG8_LAS bf16x8*)(lds + PG8_SB(b, h) + boff + n * 2048 + k * 1024); } while (0)
#define PG8_MMA(ai, bj, At, Bt) do { __builtin_amdgcn_s_setprio(1); _Pragma("unroll") for (int m = 0; m < 4; ++m) _Pragma("unroll") for (int n = 0; n < 2; ++n) _Pragma("unroll") for (int k = 0; k < 2; ++k) \
        acc[ai][bj][m][n] = __builtin_amdgcn_mfma_f32_16x16x32_bf16(Bt[n][k], At[m][k], acc[ai][bj][m][n], 0, 0, 0); __builtin_amdgcn_s_setprio(0); } while (0)
#define PG8_WAIT_V(n) asm volatile("s_waitcnt vmcnt(" #n ")" ::: "memory")
#define PG8_WAIT_L(n) asm volatile("s_waitcnt lgkmcnt(" #n ")" ::: "memory")
#define PG8_BAR __builtin_amdgcn_s_barrier()
#define PG8_SCHED __builtin_amdgcn_sched_barrier(0)
    Unit cur, nxt; int ui = 0;
    if (!S.next(0, cur)) return;
    f32x4 acc[2][2][4][2];
#pragma unroll
    for (int a = 0; a < 2; ++a)
#pragma unroll
        for (int b = 0; b < 2; ++b)
#pragma unroll
            for (int m = 0; m < 4; ++m)
#pragma unroll
                for (int n = 0; n < 2; ++n) acc[a][b][m][n] = (f32x4){0.f, 0.f, 0.f, 0.f};
    bf16x8 At[4][2], B0[2][2], B1[2][2];
    const char* cA = (const char*)g.A + (size_t)cur.pm * tstep; const char* cB = (const char*)g.Bt + (size_t)cur.pn * tstep;
    S.a_ready(cur);
    if constexpr (SP2) {
        PG8_STAGE(PG8_SB(0, 0), cB, voffB); PG8_STAGE(PG8_SB(0, 1), cB + hstep, voffB); PG8_STAGE(PG8_SA(0, 0), cA, voffA); PG8_STAGE(PG8_SA(0, 1), cA + hstep, voffA);
        if (wr == 1) PG8_BAR;
        PG8_WAIT_V(2); PG8_BAR;
        PG8_STAGE(PG8_SB(1, 0), cB + kstep, voffB); PG8_STAGE(PG8_SA(1, 0), cA + kstep, voffA); PG8_STAGE(PG8_SB(1, 1), cB + hstep + kstep, voffB);
        PG8_WAIT_V(6); PG8_BAR;
    } else {
        PG8_STAGE(PG8_SB(0, 0), cB, voffB); PG8_STAGE(PG8_SA(0, 0), cA, voffA); PG8_STAGE(PG8_SB(0, 1), cB + hstep, voffB); PG8_STAGE(PG8_SA(0, 1), cA + hstep, voffA);
        if (wr == 1) PG8_BAR;
        PG8_WAIT_V(4); PG8_BAR;
        PG8_STAGE(PG8_SB(1, 0), cB + kstep, voffB); PG8_STAGE(PG8_SA(1, 0), cA + kstep, voffA); PG8_STAGE(PG8_SB(1, 1), cB + hstep + kstep, voffB);
        PG8_WAIT_V(6); PG8_BAR;
    }
    for (;;) {
        const bool has_next = S.next(ui + 1, nxt);
        const char* nA = has_next ? (const char*)g.A + (size_t)nxt.pm * tstep : cA; const char* nB = has_next ? (const char*)g.Bt + (size_t)nxt.pn * tstep : cB;
        for (int t = 0; t < nt; t += 2) {
            const bool last = (t == nt - 2);
            const char* a1 = cA + (size_t)(t + 1) * kstep;
            const char* a2 = last ? nA : cA + (size_t)(t + 2) * kstep; const char* b2 = last ? nB : cB + (size_t)(t + 2) * kstep;
            const char* a3 = a2 + kstep; const char* b3 = b2 + kstep;
            if (last && has_next) S.a_ready(nxt);
            if constexpr (SP2) {
            PG8_LDB(B0, 0, 0); PG8_LDB(B1, 0, 1); PG8_SCHED; PG8_LDA(At, 0, 0); PG8_STAGE(PG8_SA(1, 1), a1 + hstep, voffA);
            PG8_WAIT_V(8); PG8_WAIT_L(0); PG8_BAR; PG8_MMA(0, 0, At, B0); PG8_MMA(0, 1, At, B1); PG8_BAR; PG8_SCHED;
            PG8_LDA(At, 0, 1); PG8_STAGE(PG8_SB(0, 0), b2, voffB); PG8_STAGE(PG8_SB(0, 1), b2 + hstep, voffB); PG8_STAGE(PG8_SA(0, 0), a2, voffA);
            PG8_WAIT_V(8); PG8_WAIT_L(0); PG8_BAR; PG8_MMA(1, 0, At, B0); PG8_MMA(1, 1, At, B1); PG8_BAR; PG8_SCHED;
            PG8_LDB(B0, 1, 0); PG8_LDB(B1, 1, 1); PG8_SCHED; PG8_LDA(At, 1, 0); PG8_STAGE(PG8_SA(0, 1), a2 + hstep, voffA);
            PG8_WAIT_V(8); PG8_WAIT_L(0); PG8_BAR; PG8_MMA(0, 0, At, B0); PG8_MMA(0, 1, At, B1); PG8_BAR; PG8_SCHED;
            PG8_LDA(At, 1, 1); PG8_STAGE(PG8_SB(1, 0), b3, voffB); PG8_STAGE(PG8_SB(1, 1), b3 + hstep, voffB); PG8_STAGE(PG8_SA(1, 0), a3, voffA);
            PG8_WAIT_V(8); PG8_WAIT_L(0); PG8_BAR; PG8_MMA(1, 0, At, B0); PG8_MMA(1, 1, At, B1); PG8_BAR; PG8_SCHED;
            } else {
            PG8_LDB(B0, 0, 0); PG8_SCHED; PG8_LDA(At, 0, 0); PG8_STAGE(PG8_SA(1, 1), a1 + hstep, voffA);
            PG8_WAIT_L(8); PG8_BAR; PG8_WAIT_L(0); PG8_MMA(0, 0, At, B0); PG8_BAR; PG8_SCHED;
            PG8_LDB(B1, 0, 1); PG8_STAGE(PG8_SB(0, 0), b2, voffB);
            PG8_BAR; PG8_WAIT_L(0); PG8_MMA(0, 1, At, B1); PG8_BAR;
            PG8_LDA(At, 0, 1); PG8_STAGE(PG8_SA(0, 0), a2, voffA);
            PG8_BAR; PG8_WAIT_L(0); PG8_MMA(1, 0, At, B0); PG8_BAR; PG8_SCHED;
            PG8_STAGE(PG8_SB(0, 1), b2 + hstep, voffB);
            PG8_WAIT_V(6); PG8_BAR; PG8_MMA(1, 1, At, B1); PG8_BAR;
            PG8_LDB(B0, 1, 0); PG8_SCHED; PG8_LDA(At, 1, 0); PG8_STAGE(PG8_SA(0, 1), a2 + hstep, voffA);
            PG8_WAIT_L(8); PG8_BAR; PG8_WAIT_L(0); PG8_MMA(0, 0, At, B0); PG8_BAR; PG8_SCHED;
            PG8_LDB(B1, 1, 1); PG8_STAGE(PG8_SB(1, 0), b3, voffB);
            PG8_BAR; PG8_WAIT_L(0); PG8_MMA(0, 1, At, B1); PG8_BAR;
            PG8_LDA(At, 1, 1); PG8_STAGE(PG8_SA(1, 0), a3, voffA);
            PG8_BAR; PG8_WAIT_L(0); PG8_MMA(1, 0, At, B0); PG8_BAR; PG8_SCHED;
            PG8_STAGE(PG8_SB(1, 1), b3 + hstep, voffB);
            PG8_WAIT_V(6); PG8_BAR; PG8_MMA(1, 1, At, B1); PG8_BAR;
            }
        }
        if constexpr (ALIGN_EPI) { if (wr == 0) PG8_BAR; }
        if constexpr (!Epi::AFTER_DRAIN) { E(acc, cur, wr, wc, fr, fq); S.done(cur); }
        if (!has_next) break;
#pragma unroll
        for (int a = 0; a < 2; ++a)
#pragma unroll
            for (int b = 0; b < 2; ++b)
#pragma unroll
                for (int m = 0; m < 4; ++m)
#pragma unroll
                    for (int n = 0; n < 2; ++n) acc[a][b][m][n] = (f32x4){0.f, 0.f, 0.f, 0.f};
        cur = nxt; cA = nA; cB = nB; ++ui;
        if constexpr (ALIGN_EPI) { if (wr == 1) PG8_BAR; }
    }
    PG8_WAIT_V(0);
    if constexpr (!ALIGN_EPI) { if (wr == 0) PG8_BAR; }
    PG8_BAR;
    if constexpr (Epi::AFTER_DRAIN) { E.fused(acc, cur, wr, wc, fr, fq, lds, wid, lane); S.done(cur); }
#undef PG8_SA
#undef PG8_SB
#undef PG8_STAGE
#undef PG8_LDA
#undef PG8_LDB
#undef PG8_MMA
#undef PG8_WAIT_V
#undef PG8_WAIT_L
#undef PG8_BAR
#undef PG8_SCHED
}
}

constexpr int MTOK = 8192, DM = 2048, SEQ = 2048, HW = 1024, NIN = 10240, DFF = 8192, PLE = 256;
constexpr float EPS = 1e-6f;
constexpr size_t MiB = 1u << 20;
constexpr size_t WS_SEG16 = 0;
constexpr size_t WS_LOGF = 96 * MiB;
constexpr size_t WS_HID = 0;
constexpr size_t WS_GATE = 128 * MiB;
constexpr size_t WS_X1 = 128 * MiB;
constexpr size_t WS_WIN = 192 * MiB;
constexpr size_t WS_XB = 232 * MiB;
constexpr size_t WS_UCT = 192 * MiB;
constexpr size_t WS_OA = 16 * MiB, WS_UB = 32 * MiB;
constexpr size_t WS_MERGED = 192 * MiB;
constexpr size_t WS_X1B = 232 * MiB;
constexpr size_t WS_W2T = 192 * MiB;
constexpr size_t WS_X2B = 232 * MiB;
constexpr size_t WS_WA = 264 * MiB, WS_WB = 268 * MiB, WS_WO = 272 * MiB;
constexpr size_t WS_WG = 264 * MiB, WS_WP = 272 * MiB, WS_PB = 273 * MiB;
constexpr size_t WS_INTRA = 280 * MiB;
constexpr size_t WS_W1T = 280 * MiB;
constexpr size_t WS_SMALL = 312 * MiB;
constexpr size_t WS_R0 = WS_SMALL, WS_STATS = WS_SMALL + 32768, WS_SS1 = WS_SMALL + 98304, WS_SS2 = WS_SMALL + 131072, WS_SS3 = WS_SMALL + 163840,
                 WS_LB = WS_SMALL + 196608, WS_LAM = WS_SMALL + 262144, WS_BAR = WS_SMALL + 819200, WS_BAR_BYTES = 32768, WS_PCNT = WS_BAR + 16384, WS_END = 313 * MiB;
constexpr int LDS_BYTES = 147456;

#define LAS __attribute__((address_space(3)))
typedef unsigned short bf16;
typedef unsigned v4u __attribute__((ext_vector_type(4)));
typedef unsigned v2u __attribute__((ext_vector_type(2)));
typedef float f32x4 __attribute__((ext_vector_type(4)));
typedef short bf16x8 __attribute__((ext_vector_type(8)));
#define LDS_WAIT() asm volatile("s_waitcnt lgkmcnt(0)" ::: "memory")

typedef float f32x2_t __attribute__((ext_vector_type(2))); typedef __bf16 bf16x2_t __attribute__((ext_vector_type(2)));
__device__ __forceinline__ unsigned pk2(float lo, float hi) { f32x2_t v = {lo, hi}; bf16x2_t b = __builtin_convertvector(v, bf16x2_t); return __builtin_bit_cast(unsigned, b); }
__device__ __forceinline__ float bflo(unsigned w) { return __uint_as_float(w << 16); }
__device__ __forceinline__ float bfhi(unsigned w) { return __uint_as_float(w & 0xffff0000u); }
__device__ __forceinline__ float bf2f(bf16 b) { return __uint_as_float((unsigned)b << 16); }
__device__ __forceinline__ bf16 f2bf(float f) { return (bf16)(pk2(f, 0.f) & 0xffffu); }
__device__ __forceinline__ float sigmoidf_(float v) { return __builtin_amdgcn_rcpf(1.0f + __expf(-v)); }
typedef float f32x2 __attribute__((ext_vector_type(2)));
typedef _Float16 h16x2 __attribute__((ext_vector_type(2)));
typedef _Float16 h16x8 __attribute__((ext_vector_type(8)));
__device__ __forceinline__ unsigned pkh2(float lo, float hi) { f32x2 v_ = {lo, hi}; return __builtin_bit_cast(unsigned, __builtin_convertvector(v_, h16x2)); }
__device__ __forceinline__ f32x2 gelu_pk(f32x2 v) {
    const f32x2 av = __builtin_elementwise_abs(v), d = av * 0.2316418882f + 1.0f;
    f32x2 t; t.x = __builtin_amdgcn_rcpf(d.x); t.y = __builtin_amdgcn_rcpf(d.y);
    f32x2 q = t * 0.5307027145f + (-0.7265760135f); q = q * t + 0.7107068705f; q = q * t + (-0.142248368f); q = q * t + 0.127414796f; q = q * t;
    const f32x2 s = (v * v) * (-0.72134752044f);
    f32x2 e; e.x = __builtin_amdgcn_exp2f(s.x); e.y = __builtin_amdgcn_exp2f(s.y);
    const f32x2 m = v * (q * e), r = v - m;
    f32x2 o; o.x = v.x < 0.f ? m.x : r.x; o.y = v.y < 0.f ? m.y : r.y; return o;
}
__device__ __forceinline__ float wave_sum(float v) {
#pragma unroll
    for (int o = 1; o < 64; o <<= 1) v += __shfl_xor(v, o);
    return v;
}

namespace epi {
using pg8::Unit;
struct EpiIn {
    static constexpr bool PERM = true, AFTER_DRAIN = false;
    const float* r0; const float* lb; bf16* seg16; bf16* gate; float* lgf; float* stats;
    __device__ __forceinline__ void operator()(const f32x4 (&acc)[2][2][4][2], const Unit& u, int wr, int wc, int fr, int fq) const {
        const int pn = u.pn; int mode, ld, colt; bf16* base;
        if (pn < 24) { const int s = pn >> 2; colt = (pn & 3) * 256; ld = HW; base = seg16 + (size_t)s * ((size_t)MTOK * HW); mode = (s == 0 || s == 3) ? 0 : (s == 1) ? 1 : (s == 2) ? 2 : (s == 4) ? 3 : 4; }
        else { const int s = (pn - 24) >> 3; colt = ((pn - 24) & 7) * 256; ld = DM; base = gate + (size_t)s * ((size_t)MTOK * DM); mode = 5; }
        const int row0 = u.pm * 256 + wr * 64 + fr, col0 = colt + wc * 32 + 8 * fq;
        float rsv[8];
#pragma unroll
        for (int it = 0; it < 8; ++it) rsv[it] = r0[row0 + (it >> 2) * 128 + (it & 3) * 16];
        f32x4 lbv[2][2] = {{{0.f, 0.f, 0.f, 0.f}, {0.f, 0.f, 0.f, 0.f}}, {{0.f, 0.f, 0.f, 0.f}, {0.f, 0.f, 0.f, 0.f}}};
        if (mode == 1) { lbv[0][0] = *(const f32x4*)(lb + col0); lbv[0][1] = *(const f32x4*)(lb + col0 + 4); lbv[1][0] = *(const f32x4*)(lb + col0 + 128); lbv[1][1] = *(const f32x4*)(lb + col0 + 132); }
#pragma unroll
        for (int ai = 0; ai < 2; ++ai)
#pragma unroll
            for (int m = 0; m < 4; ++m) {
                const int row = row0 + ai * 128 + m * 16; const float rs = rsv[ai * 4 + m]; float s1 = 0.f, s2 = 0.f;
#pragma unroll
                for (int bj = 0; bj < 2; ++bj) {
                    const int c = col0 + bj * 128; float v[8];
#pragma unroll
                    for (int j = 0; j < 4; ++j) { v[j] = acc[ai][bj][m][0][j] * rs; v[4 + j] = acc[ai][bj][m][1][j] * rs; }
                    if (mode == 0) {
#pragma unroll
                        for (int j = 0; j < 8; ++j) v[j] = v[j] * sigmoidf_(v[j]);
                    } else if (mode == 1) {
                        const f32x4 l0 = lbv[bj][0], l1 = lbv[bj][1]; float lg[8];
#pragma unroll
                        for (int j = 0; j < 8; ++j) { const float l = j < 4 ? l0[j] : l1[j - 4]; const float sg = sigmoidf_(v[j]); const float f = l + (1.0f - l) * sg; lg[j] = __logf(f); }
                        *(v4u*)((unsigned short*)lgf + (size_t)row * HW + c) = (v4u){pkh2(lg[0], lg[1]), pkh2(lg[2], lg[3]), pkh2(lg[4], lg[5]), pkh2(lg[6], lg[7])};
                        continue;
                    } else if (mode == 3) {
#pragma unroll
                        for (int j = 0; j < 8; j += 2) { const f32x2 g2 = gelu_pk((f32x2){v[j], v[j + 1]}); v[j] = g2.x; v[j + 1] = g2.y; }
                    } else if (mode == 4) {
#pragma unroll
                        for (int j = 0; j < 8; j += 2) { const f32x2 g2 = gelu_pk((f32x2){v[j], v[j + 1]}); v[j] = g2.x; v[j + 1] = g2.y; s1 += g2.x + g2.y; s2 += g2.x * g2.x + g2.y * g2.y; }
                    } else if (mode == 5) {
#pragma unroll
                        for (int j = 0; j < 8; ++j) v[j] = sigmoidf_(v[j]);
                    }
                    v4u w; w.x = pk2(v[0], v[1]); w.y = pk2(v[2], v[3]); w.z = pk2(v[4], v[5]); w.w = pk2(v[6], v[7]);
                    *(v4u*)(base + (size_t)row * ld + c) = w;
                }
                if (mode == 4) {
                    s1 += __shfl_xor(s1, 16); s1 += __shfl_xor(s1, 32); s2 += __shfl_xor(s2, 16); s2 += __shfl_xor(s2, 32);
                    if (fq == 0) { unsafeAtomicAdd(stats + 2 * row, s1); unsafeAtomicAdd(stats + 2 * row + 1, s2); }
                }
                asm volatile("" ::: "memory");
            }
    }
};
#define EPI_OFF(it) ((size_t)(row0 + ((it) >> 2) * 128 + ((it) & 3) * 16) * DM + col0)
#define UNPK_LO(PK_) (f32x4){bflo((PK_).x), bfhi((PK_).x), bflo((PK_).y), bfhi((PK_).y)}
#define UNPK_HI(PK_) (f32x4){bflo((PK_).z), bfhi((PK_).z), bflo((PK_).w), bfhi((PK_).w)}
struct EpiGateTmp {
    static constexpr bool PERM = true, AFTER_DRAIN = false;
    const bf16* gate; bf16* tmp;
    __device__ __forceinline__ void operator()(const f32x4 (&acc)[2][2][4][2], const Unit& u, int wr, int wc, int fr, int fq) const {
        const int row0 = u.pm * 256 + wr * 64 + fr, col0 = u.pn * 256 + wc * 32 + 8 * fq;
        if (!gate) {
#pragma unroll
            for (int it = 0; it < 8; ++it) { const size_t off = EPI_OFF(it);
#pragma unroll
                for (int bj = 0; bj < 2; ++bj) { const f32x4 a0 = acc[it >> 2][bj][it & 3][0], a1 = acc[it >> 2][bj][it & 3][1];
                    v4u w; w.x = pk2(a0[0], a0[1]); w.y = pk2(a0[2], a0[3]); w.z = pk2(a1[0], a1[1]); w.w = pk2(a1[2], a1[3]);
                    *(v4u*)(tmp + off + bj * 128) = w; } }
            return;
        }
        v4u gc[2], gn[2];
        gc[0] = __builtin_nontemporal_load((const v4u*)(gate + EPI_OFF(0))); gc[1] = __builtin_nontemporal_load((const v4u*)(gate + EPI_OFF(0) + 128));
#pragma unroll
        for (int it = 0; it < 8; ++it) { const size_t off = EPI_OFF(it);
            if (it < 7) { gn[0] = __builtin_nontemporal_load((const v4u*)(gate + EPI_OFF(it + 1))); gn[1] = __builtin_nontemporal_load((const v4u*)(gate + EPI_OFF(it + 1) + 128)); }
#pragma unroll
            for (int bj = 0; bj < 2; ++bj) { const v4u g = gc[bj];
                const f32x4 a0 = acc[it >> 2][bj][it & 3][0] * UNPK_LO(g), a1 = acc[it >> 2][bj][it & 3][1] * UNPK_HI(g);
                v4u w; w.x = pk2(a0[0], a0[1]); w.y = pk2(a0[2], a0[3]); w.z = pk2(a1[0], a1[1]); w.w = pk2(a1[2], a1[3]);
                *(v4u*)(tmp + off + bj * 128) = w; }
            gc[0] = gn[0]; gc[1] = gn[1];
            asm volatile("" ::: "memory"); }
    }
};
struct EpiMerge {
    static constexpr bool PERM = true, AFTER_DRAIN = false;
    const bf16* gate; bf16* io;
    __device__ __forceinline__ void operator()(const f32x4 (&acc)[2][2][4][2], const Unit& u, int wr, int wc, int fr, int fq) const {
        const int row0 = u.pm * 256 + wr * 64 + fr, col0 = u.pn * 256 + wc * 32 + 8 * fq;
        v4u gc[2], gn[2], tc[2], tn[2];
#define EPI_LD(G, T, it) do { const size_t o_ = EPI_OFF(it); G[0] = __builtin_nontemporal_load((const v4u*)(gate + o_)); G[1] = __builtin_nontemporal_load((const v4u*)(gate + o_ + 128)); T[0] = *(const v4u*)(io + o_); T[1] = *(const v4u*)(io + o_ + 128); } while (0)
        EPI_LD(gc, tc, 0);
#pragma unroll
        for (int it = 0; it < 8; ++it) { const size_t off = EPI_OFF(it);
            if (it < 7) EPI_LD(gn, tn, it + 1);
#pragma unroll
            for (int bj = 0; bj < 2; ++bj) { const v4u g = gc[bj], t = tc[bj];
                const f32x4 a0 = UNPK_LO(t) + acc[it >> 2][bj][it & 3][0] * UNPK_LO(g), a1 = UNPK_HI(t) + acc[it >> 2][bj][it & 3][1] * UNPK_HI(g);
                v4u w; w.x = pk2(a0[0], a0[1]); w.y = pk2(a0[2], a0[3]); w.z = pk2(a1[0], a1[1]); w.w = pk2(a1[2], a1[3]);
                *(v4u*)(io + off + bj * 128) = w; }
            gc[0] = gn[0]; gc[1] = gn[1]; tc[0] = tn[0]; tc[1] = tn[1];
            asm volatile("" ::: "memory"); }
#undef EPI_LD
    }
};
template <bool BASEB> struct EpiRes {
    static constexpr bool PERM = true, AFTER_DRAIN = false;
    const void* basep; bf16* xb; float* ss;
    __device__ __forceinline__ void operator()(const f32x4 (&acc)[2][2][4][2], const Unit& u, int wr, int wc, int fr, int fq) const {
        const int row0 = u.pm * 256 + wr * 64 + fr, col0 = u.pn * 256 + wc * 32 + 8 * fq;
        f32x4 bc[4], bn[4];
#define EPI_LD(B, it) do { const size_t o_ = EPI_OFF(it); \
            if constexpr (BASEB) { const bf16* b_ = (const bf16*)basep; const v4u w0 = *(const v4u*)(b_ + o_), w1 = *(const v4u*)(b_ + o_ + 128); B[0] = UNPK_LO(w0); B[1] = UNPK_HI(w0); B[2] = UNPK_LO(w1); B[3] = UNPK_HI(w1); } \
            else { const float* b_ = (const float*)basep; B[0] = __builtin_nontemporal_load((const f32x4*)(b_ + o_)); B[1] = __builtin_nontemporal_load((const f32x4*)(b_ + o_ + 4)); \
                   B[2] = __builtin_nontemporal_load((const f32x4*)(b_ + o_ + 128)); B[3] = __builtin_nontemporal_load((const f32x4*)(b_ + o_ + 132)); } } while (0)
        EPI_LD(bc, 0);
#pragma unroll
        for (int it = 0; it < 8; ++it) { const size_t off = EPI_OFF(it); const int row = row0 + (it >> 2) * 128 + (it & 3) * 16; float s = 0.f;
            if (it < 7) EPI_LD(bn, it + 1);
#pragma unroll
            for (int bj = 0; bj < 2; ++bj) {
                const f32x4 a0 = bc[2 * bj] + acc[it >> 2][bj][it & 3][0], a1 = bc[2 * bj + 1] + acc[it >> 2][bj][it & 3][1];
                s += (a0[0] * a0[0] + a0[1] * a0[1]) + (a0[2] * a0[2] + a0[3] * a0[3]) + (a1[0] * a1[0] + a1[1] * a1[1]) + (a1[2] * a1[2] + a1[3] * a1[3]);
                v4u w; w.x = pk2(a0[0], a0[1]); w.y = pk2(a0[2], a0[3]); w.z = pk2(a1[0], a1[1]); w.w = pk2(a1[2], a1[3]);
                *(v4u*)(xb + off + bj * 128) = w; }
            s += __shfl_xor(s, 16); s += __shfl_xor(s, 32);
            if (fq == 0) unsafeAtomicAdd(ss + row, s);
            bc[0] = bn[0]; bc[1] = bn[1]; bc[2] = bn[2]; bc[3] = bn[3];
            asm volatile("" ::: "memory"); }
#undef EPI_LD
    }
};
struct EpiFF1 {
    static constexpr bool PERM = true, AFTER_DRAIN = false;
    const float* ss; bf16* out;
    __device__ __forceinline__ void operator()(const f32x4 (&acc)[2][2][4][2], const Unit& u, int wr, int wc, int fr, int fq) const {
        const int row0 = u.pm * 256 + wr * 64 + fr, col0 = u.pn * 256 + wc * 32 + 8 * fq;
        float rsv[8];
#pragma unroll
        for (int it = 0; it < 8; ++it) rsv[it] = ss[row0 + (it >> 2) * 128 + (it & 3) * 16];
#pragma unroll
        for (int it = 0; it < 8; ++it) { const int row = row0 + (it >> 2) * 128 + (it & 3) * 16; const float rs = rsqrtf(rsv[it] * (1.0f / DM) + EPS);
#pragma unroll
            for (int bj = 0; bj < 2; ++bj) {
                float v[8];
#pragma unroll
                for (int j = 0; j < 4; ++j) { v[j] = fmaxf(acc[it >> 2][bj][it & 3][0][j] * rs, 0.f); v[j] *= v[j]; v[4 + j] = fmaxf(acc[it >> 2][bj][it & 3][1][j] * rs, 0.f); v[4 + j] *= v[4 + j]; }
                v4u w; w.x = pk2(v[0], v[1]); w.y = pk2(v[2], v[3]); w.z = pk2(v[4], v[5]); w.w = pk2(v[6], v[7]);
                *(v4u*)(out + (size_t)row * DFF + col0 + bj * 128) = w; } }
    }
};
struct EpiPleFinal {
    static constexpr bool PERM = true, AFTER_DRAIN = true;
    const bf16* x2; const float* ss2; const bf16* pp; float* out; float* ss3; const float* gfin; unsigned* cnt;
    __device__ __forceinline__ void fused(f32x4 (&acc)[2][2][4][2], const Unit& u, int wr, int wc, int fr, int fq, PG8_LAS unsigned char* lds, int wid, int lane) const {
        const int row0 = u.pm * 256 + wr * 64 + fr, col0 = u.pn * 256 + wc * 32 + 8 * fq;
        float rsv[8];
#pragma unroll
        for (int it = 0; it < 8; ++it) rsv[it] = ss2[row0 + (it >> 2) * 128 + (it & 3) * 16];
        v4u xc[2], xn[2], pc[2], pn[2];
#define EPI_LD(X, P, it) do { const size_t o_ = EPI_OFF(it); X[0] = *(const v4u*)(x2 + o_); X[1] = *(const v4u*)(x2 + o_ + 128); P[0] = *(const v4u*)(pp + o_); P[1] = *(const v4u*)(pp + o_ + 128); } while (0)
        EPI_LD(xc, pc, 0);
#pragma unroll
        for (int it = 0; it < 8; ++it) { const int row = row0 + (it >> 2) * 128 + (it & 3) * 16; const float rs = rsqrtf(rsv[it] * (1.0f / DM) + EPS); float s = 0.f;
            if (it < 7) EPI_LD(xn, pn, it + 1);
#pragma unroll
            for (int bj = 0; bj < 2; ++bj) {
#pragma unroll
                for (int n = 0; n < 2; ++n) { const f32x4 xv = n ? UNPK_HI(xc[bj]) : UNPK_LO(xc[bj]), pv = n ? UNPK_HI(pc[bj]) : UNPK_LO(pc[bj]); f32x4 r;
#pragma unroll
                    for (int j = 0; j < 4; ++j) { r[j] = xv[j] + sigmoidf_(acc[it >> 2][bj][it & 3][n][j] * rs) * pv[j]; s += r[j] * r[j]; }
                    acc[it >> 2][bj][it & 3][n] = r; } }
            s += __shfl_xor(s, 16); s += __shfl_xor(s, 32);
            if (fq == 0) unsafeAtomicAdd(ss3 + row, s);
            xc[0] = xn[0]; xc[1] = xn[1]; pc[0] = pn[0]; pc[1] = pn[1];
            asm volatile("" ::: "memory"); }
#undef EPI_LD
        asm volatile("s_waitcnt vmcnt(0)" ::: "memory");
        __syncthreads();
        if (threadIdx.x == 0) {
            unsigned* c = cnt + 64 * u.pm;
            __hip_atomic_fetch_add(c, 1u, __ATOMIC_RELAXED, __HIP_MEMORY_SCOPE_AGENT);
            unsigned sp = 0;
            while (__hip_atomic_load(c, __ATOMIC_RELAXED, __HIP_MEMORY_SCOPE_AGENT) < 8u) { __builtin_amdgcn_s_sleep(2); if (++sp > (1u << 22)) break; }
        }
        __syncthreads();
        float r3v[8]; f32x4 gf[4];
#pragma unroll
        for (int it = 0; it < 8; ++it) r3v[it] = __hip_atomic_load(ss3 + row0 + (it >> 2) * 128 + (it & 3) * 16, __ATOMIC_RELAXED, __HIP_MEMORY_SCOPE_AGENT);
#pragma unroll
        for (int k = 0; k < 4; ++k) gf[k] = *(const f32x4*)(gfin + col0 + (k >> 1) * 128 + 4 * (k & 1));
#pragma unroll
        for (int it = 0; it < 8; ++it) { const size_t off = EPI_OFF(it); const float r3 = rsqrtf(r3v[it] * (1.0f / DM) + EPS);
#pragma unroll
            for (int bj = 0; bj < 2; ++bj)
#pragma unroll
                for (int n = 0; n < 2; ++n) *(f32x4*)(out + off + bj * 128 + 4 * n) = acc[it >> 2][bj][it & 3][n] * r3 * gf[2 * bj + n]; }
    }
};
}

__device__ __forceinline__ void convert_weight(const float* __restrict__ W, int K, int N, bf16* WT, const float* __restrict__ gain, LAS unsigned char* lds, int gw, int ngw, int wave, int lane) {
    LAS float* scr = (LAS float*)(lds + wave * 16640);
    const int nblk = N / 64, nitems = (K / 64) * nblk;
    const int lrow = lane >> 4, n4 = (lane & 15) * 4, c = lane & 7, nr = lane >> 3;
    f32x4 v[16];
    int it = gw;
    if (it < nitems) { const int kb = it / nblk, nb = it - kb * nblk; const float* src = W + (size_t)(64 * kb + lrow) * N + 64 * nb + n4;
#pragma unroll
        for (int i = 0; i < 16; ++i) v[i] = __builtin_nontemporal_load((const f32x4*)(src + (size_t)(4 * i) * N)); }
    while (it < nitems) {
        const int kb = it / nblk, nb = it - kb * nblk, k0 = 64 * kb, n0 = 64 * nb;
        f32x4 g0 = {1.f, 1.f, 1.f, 1.f}, g1 = {1.f, 1.f, 1.f, 1.f};
        if (gain) { g0 = *(const f32x4*)(gain + k0 + 8 * c); g1 = *(const f32x4*)(gain + k0 + 8 * c + 4); }
#pragma unroll
        for (int i = 0; i < 16; ++i) { LAS float* d = scr + (4 * i + lrow) * 65 + n4; d[0] = v[i][0]; d[1] = v[i][1]; d[2] = v[i][2]; d[3] = v[i][3]; }
        const int nx = it + ngw;
        if (nx < nitems) { const int kb2 = nx / nblk, nb2 = nx - kb2 * nblk; const float* src = W + (size_t)(64 * kb2 + lrow) * N + 64 * nb2 + n4;
#pragma unroll
            for (int i = 0; i < 16; ++i) v[i] = __builtin_nontemporal_load((const f32x4*)(src + (size_t)(4 * i) * N)); }
        LDS_WAIT();
#pragma unroll
        for (int jj = 0; jj < 8; ++jj) { const int n = nr + 8 * jj; const LAS float* s = scr + (8 * c) * 65 + n;
            v4u o; o.x = pk2(s[0 * 65] * g0[0], s[1 * 65] * g0[1]); o.y = pk2(s[2 * 65] * g0[2], s[3 * 65] * g0[3]); o.z = pk2(s[4 * 65] * g1[0], s[5 * 65] * g1[1]); o.w = pk2(s[6 * 65] * g1[2], s[7 * 65] * g1[3]);
            *(v4u*)(WT + (size_t)(n0 + n) * K + k0 + 8 * c) = o; }
        LDS_WAIT();
        it = nx;
    }
}

constexpr int H_G = 0, H_PART = 32768, H_QT = 34816, H_KT = 52224, H_KH = 69632, H_VT = 88064, H_AT = 106496;
constexpr int LDQ = 136, LDS64 = 72;
__device__ __forceinline__ void hgrn_local_phase(int first, int step, LAS unsigned char* lds, bf16* Q, const bf16* Kb, const bf16* V, const float* LOGF, bf16* INTRA, bf16* UCT, float* LAM, int tid) {
    const int lane = tid & 63, w = tid >> 6;
    const int d = tid & 127, part = tid >> 7, t0 = part * 16;
    LAS float* G = (LAS float*)(lds + H_G); LAS float* PART = (LAS float*)(lds + H_PART);
    LAS bf16* QT = (LAS bf16*)(lds + H_QT); LAS bf16* KT = (LAS bf16*)(lds + H_KT); LAS bf16* KH = (LAS bf16*)(lds + H_KH); LAS bf16* VT = (LAS bf16*)(lds + H_VT); LAS bf16* AT = (LAS bf16*)(lds + H_AT);
    h16x8 gr[2]; v4u vr[2]; bf16 qv[16]; float kv[16];
#define HG_LOAD(IT) do { const int c_ = (IT) & 31, h_ = ((IT) >> 5) & 7, b_ = (IT) >> 8; const size_t rb_ = (size_t)b_ * SEQ + c_ * 64; const int cl_ = h_ * 128; \
        _Pragma("unroll") for (int i = 0; i < 2; ++i) { const int idx = i * 512 + tid, t = idx >> 4, c8 = (idx & 15) * 8; gr[i] = *(const h16x8*)((const _Float16*)LOGF + (rb_ + t) * HW + cl_ + c8); } \
        _Pragma("unroll") for (int i = 0; i < 2; ++i) { const int idx = i * 512 + tid, s_ = idx & 63, e0 = (idx >> 6) * 8; vr[i] = *(const v4u*)(V + (rb_ + s_) * HW + cl_ + e0); } \
        _Pragma("unroll") for (int i = 0; i < 16; ++i) { qv[i] = Q[(rb_ + t0 + i) * HW + cl_ + d]; } } while (0)
    if (first < 1024) HG_LOAD(first);
    for (int item = first; item < 1024; item += step) {
    const int c = item & 31, h = (item >> 5) & 7, b = item >> 8;
    const size_t rowbase = (size_t)b * SEQ + c * 64; const int col0 = h * 128;
#pragma unroll
    for (int i = 0; i < 2; ++i) { const int idx = i * 512 + tid, t = idx >> 4, c8 = (idx & 15) * 8; const h16x8 hv = gr[i];
        *(LAS f32x4*)(G + t * 128 + c8) = (f32x4){(float)hv[0], (float)hv[1], (float)hv[2], (float)hv[3]}; *(LAS f32x4*)(G + t * 128 + c8 + 4) = (f32x4){(float)hv[4], (float)hv[5], (float)hv[6], (float)hv[7]}; }
#pragma unroll
    for (int i = 0; i < 2; ++i) { const int idx = i * 512 + tid, s = idx & 63, e0 = (idx >> 6) * 8; const v4u x = vr[i];
        VT[(e0 + 0) * LDS64 + s] = (bf16)(x.x & 0xffff); VT[(e0 + 1) * LDS64 + s] = (bf16)(x.x >> 16); VT[(e0 + 2) * LDS64 + s] = (bf16)(x.y & 0xffff); VT[(e0 + 3) * LDS64 + s] = (bf16)(x.y >> 16);
        VT[(e0 + 4) * LDS64 + s] = (bf16)(x.z & 0xffff); VT[(e0 + 5) * LDS64 + s] = (bf16)(x.z >> 16); VT[(e0 + 6) * LDS64 + s] = (bf16)(x.w & 0xffff); VT[(e0 + 7) * LDS64 + s] = (bf16)(x.w >> 16); }
    __syncthreads();
    float bl[16]; { float run = 0.f;
#pragma unroll
        for (int i = 0; i < 16; ++i) { const float g_ = G[(t0 + i) * 128 + d]; kv[i] = 1.0f - __expf(g_); run += g_; bl[i] = run; } PART[part * 128 + d] = run; }
    __syncthreads();
    float offs = 0.f, blast = 0.f;
#pragma unroll
    for (int p = 0; p < 4; ++p) { const float pv = PART[p * 128 + d]; blast += pv; if (p < part) offs += pv; }
    if (part == 0) LAM[(size_t)item * 128 + d] = __expf(blast);
    unsigned khp[8];
#pragma unroll
    for (int i = 0; i < 16; i += 2) {
        float kh2[2];
#pragma unroll
        for (int j = 0; j < 2; ++j) { const float bt = offs + bl[i + j]; const float q = bf2f(qv[i + j]), k = kv[i + j];
            const bf16 qt = f2bf(q * __expf(bt)); QT[(t0 + i + j) * LDQ + d] = qt; Q[(rowbase + t0 + i + j) * HW + col0 + d] = qt;
            KT[(t0 + i + j) * LDQ + d] = f2bf(k * __expf(-bt)); kh2[j] = k * __expf(blast - bt); }
        khp[i >> 1] = pk2(kh2[0], kh2[1]);
    }
    *(LAS v4u*)(KH + d * LDS64 + t0) = (v4u){khp[0], khp[1], khp[2], khp[3]}; *(LAS v4u*)(KH + d * LDS64 + t0 + 8) = (v4u){khp[4], khp[5], khp[6], khp[7]};
    __syncthreads();
    if (item + step < 1024) HG_LOAD(item + step);
    const int lr = lane & 15, lq = lane >> 4;
#pragma unroll
    for (int r = 0; r < 2; ++r) { const int id = w + 8 * r, ts = id >> 2, tt = id & 3; f32x4 a = {0.f, 0.f, 0.f, 0.f};
        if (ts <= tt) {
#pragma unroll
            for (int ks = 0; ks < 4; ++ks) { const bf16x8 fa = *(const LAS bf16x8*)(KT + (ts * 16 + lr) * LDQ + ks * 32 + 8 * lq), fb = *(const LAS bf16x8*)(QT + (tt * 16 + lr) * LDQ + ks * 32 + 8 * lq);
                a = __builtin_amdgcn_mfma_f32_16x16x32_bf16(fa, fb, a, 0, 0, 0); } }
        const int t = tt * 16 + lr, s0 = ts * 16 + lq * 4;
        const float m0 = (s0 + 0 <= t) ? a[0] : 0.f, m1 = (s0 + 1 <= t) ? a[1] : 0.f, m2 = (s0 + 2 <= t) ? a[2] : 0.f, m3 = (s0 + 3 <= t) ? a[3] : 0.f;
        *(LAS v2u*)(AT + t * LDS64 + s0) = (v2u){pk2(m0, m1), pk2(m2, m3)}; }
    __syncthreads();
    const bf16x8 vf0 = *(const LAS bf16x8*)(VT + (w * 16 + lr) * LDS64 + 8 * lq), vf1 = *(const LAS bf16x8*)(VT + (w * 16 + lr) * LDS64 + 32 + 8 * lq);
#pragma unroll
    for (int tt = 0; tt < 4; ++tt) { f32x4 a = {0.f, 0.f, 0.f, 0.f};
        const bf16x8 f0 = *(const LAS bf16x8*)(AT + (tt * 16 + lr) * LDS64 + 8 * lq), f1 = *(const LAS bf16x8*)(AT + (tt * 16 + lr) * LDS64 + 32 + 8 * lq);
        a = __builtin_amdgcn_mfma_f32_16x16x32_bf16(vf0, f0, a, 0, 0, 0); a = __builtin_amdgcn_mfma_f32_16x16x32_bf16(vf1, f1, a, 0, 0, 0);
        *(v2u*)(INTRA + (rowbase + tt * 16 + lr) * HW + col0 + w * 16 + lq * 4) = (v2u){pk2(a[0], a[1]), pk2(a[2], a[3])}; }
    bf16* uo = UCT + (size_t)item * 16384 + (w * 16 + lr) * 128 + lq * 4;
#pragma unroll
    for (int dt = 0; dt < 8; ++dt) { f32x4 a = {0.f, 0.f, 0.f, 0.f};
        const bf16x8 f0 = *(const LAS bf16x8*)(KH + (dt * 16 + lr) * LDS64 + 8 * lq), f1 = *(const LAS bf16x8*)(KH + (dt * 16 + lr) * LDS64 + 32 + 8 * lq);
        a = __builtin_amdgcn_mfma_f32_16x16x32_bf16(f0, vf0, a, 0, 0, 0); a = __builtin_amdgcn_mfma_f32_16x16x32_bf16(f1, vf1, a, 0, 0, 0);
        *(v2u*)(uo + dt * 16) = (v2u){pk2(a[0], a[1]), pk2(a[2], a[3])}; }
    __syncthreads();
    }
#undef HG_LOAD
}
__device__ __forceinline__ void hgrn_scan(bf16* UCT, const float* LAM, int gtid, int gthreads) {
    for (int i = gtid; i < 32 * 128 * 32; i += gthreads) {
        const int bh = i >> 12, e = (i >> 5) & 127, d0 = (i & 31) * 4;
        bf16* p = UCT + (size_t)bh * 32 * 16384 + e * 128 + d0; const float* lp = LAM + (size_t)bh * 32 * 128 + d0;
        f32x4 S = {0.f, 0.f, 0.f, 0.f};
#pragma unroll 16
        for (int c = 0; c < 32; ++c) {
            const v2u uu = *(const v2u*)(p + (size_t)c * 16384); const f32x4 lam = *(const f32x4*)(lp + c * 128);
            *(v2u*)(p + (size_t)c * 16384) = (v2u){pk2(S[0], S[1]), pk2(S[2], S[3])};
            S = lam * S + (f32x4){bflo(uu.x), bfhi(uu.x), bflo(uu.y), bfhi(uu.y)};
        }
    }
}
__device__ __forceinline__ void hgrn_out_phase(int first, int step, int wave, int lane, const bf16* Qt, const bf16* SP, const bf16* INTRA, const bf16* Gs, const float* hn, bf16* OA) {
    const int wl = wave & 3, lr = lane & 15, lq = lane >> 4;
    f32x4 hn8[8];
#pragma unroll
    for (int et = 0; et < 8; ++et) hn8[et] = *(const f32x4*)(hn + et * 16 + lq * 4);
    bf16x8 bq[4]; v2u in8[8]; v2u gg8[8], ggn[8];
#define HO_ROW(PI) ((size_t)(((PI) * 2 + (wave >> 2)) >> 8) * SEQ + (((PI) * 2 + (wave >> 2)) & 31) * 64 + wl * 16 + lr)
#define HO_COL(PI) (((((PI) * 2 + (wave >> 2)) >> 5) & 7) * 128)
#define HO_LOAD_A(PI) do { const size_t r_ = HO_ROW(PI); const int c_ = HO_COL(PI); \
        _Pragma("unroll") for (int ks = 0; ks < 4; ++ks) bq[ks] = *(const bf16x8*)(Qt + r_ * HW + c_ + ks * 32 + 8 * lq); \
        _Pragma("unroll") for (int et = 0; et < 8; ++et) in8[et] = *(const v2u*)(INTRA + r_ * HW + c_ + et * 16 + lq * 4); } while (0)
#define HO_LOAD_G(DST, PI) do { const size_t r_ = HO_ROW(PI); const int c_ = HO_COL(PI); \
        _Pragma("unroll") for (int et = 0; et < 8; ++et) DST[et] = *(const v2u*)(Gs + r_ * HW + c_ + et * 16 + lq * 4); } while (0)
    if (first < 512) { HO_LOAD_A(first); HO_LOAD_G(gg8, first); }
    for (int pi = first; pi < 512; pi += step) {
        const int item = pi * 2 + (wave >> 2);
        const size_t row = HO_ROW(pi); const int col0 = HO_COL(pi);
        const bf16* sp = SP + (size_t)item * 16384 + lr * 128 + 8 * lq;
        f32x4 o[8]; float ss = 0.f;
#pragma unroll
        for (int et = 0; et < 8; ++et) { f32x4 a = (f32x4){bflo(in8[et].x), bfhi(in8[et].x), bflo(in8[et].y), bfhi(in8[et].y)};
#pragma unroll
            for (int ks = 0; ks < 4; ++ks) { const bf16x8 fa = *(const bf16x8*)(sp + et * 2048 + ks * 32); a = __builtin_amdgcn_mfma_f32_16x16x32_bf16(fa, bq[ks], a, 0, 0, 0); }
            o[et] = a; ss += (a[0] * a[0] + a[1] * a[1]) + (a[2] * a[2] + a[3] * a[3]); }
        const bool more = pi + step < 512;
        if (more) { HO_LOAD_A(pi + step); HO_LOAD_G(ggn, pi + step); }
        ss += __shfl_xor(ss, 16); ss += __shfl_xor(ss, 32);
        const float rn = rsqrtf(ss * (1.0f / 128.0f) + EPS);
#pragma unroll
        for (int et = 0; et < 8; ++et) { const int e0 = et * 16 + lq * 4; const f32x4 g4 = hn8[et]; const v2u gg = gg8[et];
            const float r0 = o[et][0] * rn * g4[0] * bflo(gg.x), r1 = o[et][1] * rn * g4[1] * bfhi(gg.x), r2 = o[et][2] * rn * g4[2] * bflo(gg.y), r3 = o[et][3] * rn * g4[3] * bfhi(gg.y);
            *(v2u*)(OA + row * HW + col0 + e0) = (v2u){pk2(r0, r1), pk2(r2, r3)}; }
#pragma unroll
        for (int et = 0; et < 8; ++et) gg8[et] = ggn[et];
    }
#undef HO_ROW
#undef HO_COL
#undef HO_LOAD_A
#undef HO_LOAD_G
}

constexpr int S_W = 0, S_VN = 34816, S_ST = 69632;
__device__ __forceinline__ void gmlp_phase(int first, int step, LAS unsigned char* lds, const bf16* GV, const bf16* U, const float* stats, const float* lng, const float* lnb, const float* wsp, const float* bsp, bf16* UB, int tid) {
    const int lane = tid & 63, w = tid >> 6, lr = lane & 15, lq = lane >> 4;
    LAS bf16* WS = (LAS bf16*)(lds + S_W); LAS bf16* VN = (LAS bf16*)(lds + S_VN); LAS float* ST = (LAS float*)(lds + S_ST);
    v4u gvr[4]; float smr = 0.f, sqr = 0.f; int hs = -1;
#define GM_LOAD(IT) do { const int h_ = (IT) & 7, g_ = ((IT) >> 3) & 15, b_ = (IT) >> 7; const size_t rb_ = (size_t)b_ * SEQ + g_ * 128; \
        _Pragma("unroll") for (int i = 0; i < 4; ++i) { const int idx = i * 512 + tid, s_ = idx & 127, c0_ = (idx >> 7) * 8; gvr[i] = *(const v4u*)(GV + (rb_ + s_) * HW + h_ * 128 + c0_); } \
        if (tid < 128) { smr = stats[2 * (rb_ + tid)]; sqr = stats[2 * (rb_ + tid) + 1]; } } while (0)
    if (first < 512) GM_LOAD(first);
    for (int item = first; item < 512; item += step) {
        const int h = item & 7, g = (item >> 3) & 15, b = item >> 7;
        const size_t rowbase = (size_t)b * SEQ + g * 128; const int col0 = h * 128;
        if (tid < 128) { const float mu = smr * (1.0f / HW), var = sqr * (1.0f / HW) - mu * mu; ST[2 * tid] = mu; ST[2 * tid + 1] = rsqrtf(var + EPS); }
        if (h != hs) { hs = h;
#pragma unroll
            for (int i = 0; i < 8; ++i) { const int idx = i * 512 + tid, t = idx >> 5, s4 = (idx & 31) * 4; f32x4 x = *(const f32x4*)(wsp + ((size_t)h * 128 + t) * 128 + s4);
                if (t < 64 && s4 >= 64) x = (f32x4){0.f, 0.f, 0.f, 0.f};
                *(LAS v2u*)(WS + t * LDQ + s4) = (v2u){pk2(x[0], x[1]), pk2(x[2], x[3])}; } }
        v2u uu8[8]; float bs8[8];
#pragma unroll
        for (int tt = 0; tt < 8; ++tt) { uu8[tt] = *(const v2u*)(U + (rowbase + tt * 16 + lr) * HW + col0 + w * 16 + lq * 4); bs8[tt] = bsp[h * 128 + tt * 16 + lr]; }
        __syncthreads();
#pragma unroll
        for (int i = 0; i < 4; ++i) { const int idx = i * 512 + tid, s = idx & 127, c0 = (idx >> 7) * 8;
            const v4u x = gvr[i]; const float mu = ST[2 * s], rs = ST[2 * s + 1];
            const f32x4 g0 = *(const f32x4*)(lng + col0 + c0), g1 = *(const f32x4*)(lng + col0 + c0 + 4), b0 = *(const f32x4*)(lnb + col0 + c0), b1 = *(const f32x4*)(lnb + col0 + c0 + 4);
            VN[(c0 + 0) * LDQ + s] = f2bf((bflo(x.x) - mu) * rs * g0[0] + b0[0]); VN[(c0 + 1) * LDQ + s] = f2bf((bfhi(x.x) - mu) * rs * g0[1] + b0[1]);
            VN[(c0 + 2) * LDQ + s] = f2bf((bflo(x.y) - mu) * rs * g0[2] + b0[2]); VN[(c0 + 3) * LDQ + s] = f2bf((bfhi(x.y) - mu) * rs * g0[3] + b0[3]);
            VN[(c0 + 4) * LDQ + s] = f2bf((bflo(x.z) - mu) * rs * g1[0] + b1[0]); VN[(c0 + 5) * LDQ + s] = f2bf((bfhi(x.z) - mu) * rs * g1[1] + b1[1]);
            VN[(c0 + 6) * LDQ + s] = f2bf((bflo(x.w) - mu) * rs * g1[2] + b1[2]); VN[(c0 + 7) * LDQ + s] = f2bf((bfhi(x.w) - mu) * rs * g1[3] + b1[3]); }
        __syncthreads();
        if (item + step < 512) GM_LOAD(item + step);
        bf16x8 fa[4];
#pragma unroll
        for (int ks = 0; ks < 4; ++ks) fa[ks] = *(const LAS bf16x8*)(VN + (w * 16 + lr) * LDQ + ks * 32 + 8 * lq);
#pragma unroll
        for (int tt = 0; tt < 8; ++tt) { f32x4 a = {0.f, 0.f, 0.f, 0.f};
#pragma unroll
            for (int ks = 0; ks < 4; ++ks) { if (tt < 4 && ks >= 2) continue; const bf16x8 fb = *(const LAS bf16x8*)(WS + (tt * 16 + lr) * LDQ + ks * 32 + 8 * lq); a = __builtin_amdgcn_mfma_f32_16x16x32_bf16(fa[ks], fb, a, 0, 0, 0); }
            const int t = tt * 16 + lr, c0 = w * 16 + lq * 4; const float bs = bs8[tt];
            const size_t o = (rowbase + t) * HW + col0 + c0; const v2u uu = uu8[tt];
            *(v2u*)(UB + o) = (v2u){pk2(bflo(uu.x) * (a[0] + bs), bfhi(uu.x) * (a[1] + bs)), pk2(bflo(uu.y) * (a[2] + bs), bfhi(uu.y) * (a[3] + bs))}; }
        __syncthreads();
    }
#undef GM_LOAD
}

#define RLX_AGENT __ATOMIC_RELAXED, __HIP_MEMORY_SCOPE_AGENT
#define XB_TMO      128
#define XB_XCNT(j)  (256  + 64 * (j))
#define XB_XSUB(j)  (1280 + 64 * (j))
#define XB_XGEN(j)  (2304 + 64 * (j))
#define XB_TOP      3328
#define XB_TOPGEN   3392
#define XCD_BAR_WORDS 3456
#define XB_SPIN_CAP (1u << 18)

__device__ __forceinline__ unsigned xb_ld(unsigned* p)              { return __hip_atomic_load(p, __ATOMIC_RELAXED, __HIP_MEMORY_SCOPE_AGENT); }
__device__ __forceinline__ unsigned xb_add(unsigned* p, unsigned v) { return __hip_atomic_fetch_add(p, v, __ATOMIC_RELAXED, __HIP_MEMORY_SCOPE_AGENT); }
__device__ __forceinline__ unsigned xb_xcc_id() { return (unsigned)__builtin_amdgcn_s_getreg((3 << 11) | 20) & 0xFu; }
#define XB_SPIN(cond, bar) do { unsigned _sp = 0; while (cond) { __builtin_amdgcn_s_sleep(1); \
    if ((++_sp & 255u) == 0u) { if (xb_ld(&(bar)[XB_TMO])) break; if (_sp > XB_SPIN_CAP) { atomicAdd(&(bar)[XB_TMO], 1u); break; } } } } while (0)

struct XcdBarrier {
    unsigned* bar; unsigned x;
    volatile LAS unsigned* st;
};

__device__ __forceinline__ XcdBarrier xcd_barrier_post(unsigned* bar, volatile LAS unsigned* st) {
    XcdBarrier b; b.bar = bar; b.x = xb_xcc_id(); b.st = st;
    if (threadIdx.x == 0) st[2] = xb_add(&bar[XB_XCNT(b.x)], 1u);
    return b;
}
__device__ __forceinline__ void xcd_barrier_complete(unsigned* bar, unsigned x, unsigned& nloc, unsigned& nx) {
    const unsigned G = gridDim.x * gridDim.y * gridDim.z;
    unsigned sum, cnt, mine, sp = 0u;
    for (;;) {
        sum = 0u; cnt = 0u; mine = 0u;
#pragma unroll
        for (unsigned j = 0; j < 16; ++j) { const unsigned c = xb_ld(&bar[XB_XCNT(j)]); sum += c; cnt += (c > 0u) ? 1u : 0u; mine = (j == x) ? c : mine; }
        if (sum == G) break;
        __builtin_amdgcn_s_sleep(1);
        if ((++sp & 255u) == 0u) { if (xb_ld(&bar[XB_TMO])) break; if (sp > XB_SPIN_CAP) { atomicAdd(&bar[XB_TMO], 1u); break; } }
    }
    nloc = mine > 0u ? mine : 1u; nx = cnt > 0u ? cnt : 1u;
}

__device__ __forceinline__ void xcd_barrier(const XcdBarrier& b) {
    asm volatile("s_waitcnt vmcnt(0)" ::: "memory");
    __syncthreads();
    if (threadIdx.x == 0) {
        unsigned* bar = b.bar;
        __builtin_amdgcn_s_waitcnt(0);
        unsigned nloc = b.st[0], nx = b.st[1];
        if (nloc == 0u) { xcd_barrier_complete(bar, b.x, nloc, nx); b.st[0] = nloc; b.st[1] = nx; }
        const unsigned old = xb_add(&bar[XB_XSUB(b.x)], 1u);
        const unsigned gen = old / nloc;
        if (old + 1u == (gen + 1u) * nloc) {
            __builtin_amdgcn_fence(__ATOMIC_RELEASE, "agent");
            asm volatile("s_waitcnt vmcnt(0)" ::: "memory");
            const unsigned og = xb_add(&bar[XB_TOP], 1u);
            const unsigned tg = og / nx;
            if (og + 1u == (tg + 1u) * nx) xb_add(&bar[XB_TOPGEN], 1u);
            else XB_SPIN(xb_ld(&bar[XB_TOPGEN]) == tg, bar);
            __builtin_amdgcn_fence(__ATOMIC_ACQUIRE, "agent");
            xb_add(&bar[XB_XGEN(b.x)], 1u);
            asm volatile("s_waitcnt vmcnt(0)" ::: "memory");
        } else {
            XB_SPIN(xb_ld(&bar[XB_XGEN(b.x)]) == gen, bar);
            __builtin_amdgcn_fence(__ATOMIC_ACQUIRE, "agent");
            asm volatile("s_waitcnt vmcnt(0)" ::: "memory");
        }
    }
    __syncthreads();
}

struct Args { const float* in[20]; float* out; unsigned char* ws; int ph_lo, ph_hi; };
constexpr int NPH = 10;
__global__ void __launch_bounds__(512, 2) fwd_kernel(Args args) {
    extern __shared__ __attribute__((aligned(16))) unsigned char lds_raw[];
    LAS unsigned char* lds = (LAS unsigned char*)lds_raw;
    const int tid = threadIdx.x, lane = tid & 63, wave = __builtin_amdgcn_readfirstlane(tid >> 6);
    const int G = gridDim.x, bid = blockIdx.x, gw = bid * 8 + wave, ngw = G * 8;
    unsigned char* ws = args.ws;
    const float* x = args.in[0]; const float* p = args.in[1]; const float* norm_mix = args.in[2]; const float* w_in = args.in[3]; const float* lb_logits = args.in[4];
    const float* hgrn_norm = args.in[5]; const float* w_a_out = args.in[6]; const float* ln_g = args.in[7]; const float* ln_b = args.in[8]; const float* w_spatial = args.in[9];
    const float* b_spatial = args.in[10]; const float* w_b_out = args.in[11]; const float* w_o = args.in[12]; const float* norm_ffn = args.in[13]; const float* w_ff1 = args.in[14];
    const float* w_ff2 = args.in[15]; const float* norm_ple = args.in[16]; const float* w_ple_gate = args.in[17]; const float* w_ple_proj = args.in[18]; const float* norm_final = args.in[19];
    float* out = args.out;
    bf16* SEG16 = (bf16*)(ws + WS_SEG16); float* LOGF = (float*)(ws + WS_LOGF); bf16* HID = (bf16*)(ws + WS_HID); bf16* GATE = (bf16*)(ws + WS_GATE); float* X1 = (float*)(ws + WS_X1);
    bf16* WIN = (bf16*)(ws + WS_WIN); bf16* XB = (bf16*)(ws + WS_XB); bf16* UCT = (bf16*)(ws + WS_UCT); bf16* OA = (bf16*)(ws + WS_OA); bf16* UBUF = (bf16*)(ws + WS_UB);
    bf16* MERGED = (bf16*)(ws + WS_MERGED); bf16* X1B = (bf16*)(ws + WS_X1B); bf16* W2T = (bf16*)(ws + WS_W2T); bf16* X2B = (bf16*)(ws + WS_X2B);
    bf16* WA = (bf16*)(ws + WS_WA); bf16* WB = (bf16*)(ws + WS_WB); bf16* WO = (bf16*)(ws + WS_WO); bf16* WG = (bf16*)(ws + WS_WG); bf16* WP = (bf16*)(ws + WS_WP); bf16* PB = (bf16*)(ws + WS_PB);
    bf16* INTRA = (bf16*)(ws + WS_INTRA); bf16* W1T = (bf16*)(ws + WS_W1T);
    float* R0 = (float*)(ws + WS_R0); float* STATS = (float*)(ws + WS_STATS); float* SS1 = (float*)(ws + WS_SS1); float* SS2 = (float*)(ws + WS_SS2); float* SS3 = (float*)(ws + WS_SS3);
    float* LB = (float*)(ws + WS_LB); float* LAM = (float*)(ws + WS_LAM);
    bf16* Qb = SEG16; bf16* Kb = SEG16 + (size_t)1 * MTOK * HW; bf16* Vb = SEG16 + (size_t)2 * MTOK * HW; bf16* Gb = SEG16 + (size_t)3 * MTOK * HW; bf16* Ub = SEG16 + (size_t)4 * MTOK * HW; bf16* GVb = SEG16 + (size_t)5 * MTOK * HW;
    bf16* GA = GATE; bf16* GBt = GATE + (size_t)MTOK * DM;

    const int lo = args.ph_lo, hi = args.ph_hi;
    volatile LAS unsigned* bst = (volatile LAS unsigned*)(lds + LDS_BYTES - 64);
    if (tid < 4) bst[tid] = 0u;
    __syncthreads();
    const XcdBarrier xbar = xcd_barrier_post((unsigned*)(ws + WS_BAR), bst);
#ifdef DBG_K
    for (size_t i = (size_t)bid * 512 + tid; i < (size_t)MTOK * DM; i += (size_t)G * 512) out[i] = 1.0f;
#endif
#define IN(k) (lo <= (k) && (k) < hi)
#define SEAM(k) do { if (IN(k) && IN((k) + 1)) { xcd_barrier(xbar); } } while (0)
#define GEMM(EpiT, E, Aop, Bop, Nn, Kk) do { pg8::Gemm g_{(const pg8::bf16_t*)(Aop), (const pg8::bf16_t*)(Bop), MTOK, (Nn), (Kk)}; pg8::StaticOrder S_; S_.init(MTOK, (Nn), G, vb); \
        pg8::gemm_phase<EpiT, pg8::StaticOrder, true, true>(lds, g_, S_, (E)); } while (0)

    if (IN(0)) {
        convert_weight(w_in, DM, NIN, WIN, norm_mix, lds, gw, ngw, wave, lane);
        convert_weight(w_a_out, HW, DM, WA, nullptr, lds, (gw + ngw - (ngw >> 1)) % ngw, ngw, wave, lane);
        convert_weight(w_b_out, HW, DM, WB, nullptr, lds, (gw + ngw - (ngw >> 1) - (ngw >> 3)) % ngw, ngw, wave, lane);
        convert_weight(w_o, DM, DM, WO, nullptr, lds, (gw + ngw - (ngw >> 1) - (ngw >> 2)) % ngw, ngw, wave, lane);
        { f32x4 xv[8], xw[8];
            if (gw < MTOK) { const f32x4* xr = (const f32x4*)(x + (size_t)gw * DM) + lane;
#pragma unroll
                for (int j = 0; j < 8; ++j) xv[j] = __builtin_nontemporal_load(xr + 64 * j); }
            for (int m = gw; m < MTOK; m += ngw) {
                if (m + ngw < MTOK) { const f32x4* xr = (const f32x4*)(x + (size_t)(m + ngw) * DM) + lane;
#pragma unroll
                    for (int j = 0; j < 8; ++j) xw[j] = __builtin_nontemporal_load(xr + 64 * j); }
                unsigned long long* o8 = (unsigned long long*)(XB + (size_t)m * DM) + lane; float sq = 0.f;
#pragma unroll
                for (int j = 0; j < 8; ++j) { const f32x4 v = xv[j]; sq += (v[0] * v[0] + v[1] * v[1]) + (v[2] * v[2] + v[3] * v[3]); o8[64 * j] = (unsigned long long)pk2(v[0], v[1]) | ((unsigned long long)pk2(v[2], v[3]) << 32); }
                sq = wave_sum(sq); if (lane == 0) R0[m] = rsqrtf(sq * (1.0f / DM) + EPS);
#pragma unroll
                for (int j = 0; j < 8; ++j) xv[j] = xw[j];
            } }
        for (int i = bid * 512 + tid; i < 40960; i += G * 512) STATS[i] = 0.f;
        for (int i = bid * 512 + tid; i < HW; i += G * 512) { const float l0 = lb_logits[i], l1 = lb_logits[HW + i], mx = fmaxf(l0, l1), e0 = expf(l0 - mx), e1 = expf(l1 - mx); LB[i] = e0 / (e0 + e1); }
    }
    SEAM(0);
    int vb = bid;
    if (IN(0) && IN(1)) {
        if (tid == 0) { unsigned* bar_ = (unsigned*)(ws + WS_BAR); bool ok = (G == 256);
            for (unsigned j = 0; j < 16; ++j) { const unsigned c_ = xb_ld(&bar_[XB_XCNT(j)]); ok = ok && (c_ == (j < 8 ? 32u : 0u)); }
            bst[3] = (ok && xbar.x < 8u && bst[2] < 32u) ? (bst[2] * 8u + xbar.x) : (unsigned)bid; }
        __syncthreads();
        vb = (int)bst[3];
    }
    if (IN(1)) { epi::EpiIn E{R0, LB, SEG16, GATE, LOGF, STATS}; GEMM(epi::EpiIn, E, XB, WIN, NIN, DM); }
    SEAM(1);
    if (IN(2)) { hgrn_local_phase(bid, G, lds, Qb, Kb, Vb, LOGF, INTRA, UCT, LAM, tid); }
    SEAM(2);
    if (IN(3)) { hgrn_scan(UCT, LAM, bid * 512 + tid, G * 512);
        gmlp_phase(bid, G, lds, GVb, Ub, STATS, ln_g, ln_b, w_spatial, b_spatial, UBUF, tid); }
    SEAM(3);
    if (IN(4)) { hgrn_out_phase(bid, G, wave, lane, Qb, UCT, INTRA, Gb, hgrn_norm, OA); }
    SEAM(4);
    if (IN(5)) {
        convert_weight(w_ff1, DM, DFF, W1T, norm_ffn, lds, gw, ngw, wave, lane); __syncthreads();
        { epi::EpiGateTmp E{GA, MERGED}; GEMM(epi::EpiGateTmp, E, OA, WA, DM, HW); }
        { epi::EpiMerge E{GBt, MERGED}; GEMM(epi::EpiMerge, E, UBUF, WB, DM, HW); }
    }
    SEAM(5);
    if (IN(6)) { epi::EpiRes<true> E{X1B, X1B, SS1}; GEMM(epi::EpiRes<true>, E, MERGED, WO, DM, DM); }
    SEAM(6);
    if (IN(7)) { convert_weight(w_ff2, DFF, DM, W2T, nullptr, lds, gw, ngw, wave, lane);
        convert_weight(w_ple_gate, DM, DM, WG, norm_ple, lds, gw, ngw, wave, lane);
        convert_weight(w_ple_proj, PLE, DM, WP, nullptr, lds, (gw + ngw - (ngw >> 1)) % ngw, ngw, wave, lane);
        for (int i = bid * 512 + tid; i < MTOK * PLE / 4; i += G * 512) { const f32x4 v = __builtin_nontemporal_load((const f32x4*)p + i); ((v2u*)PB)[i] = (v2u){pk2(v[0], v[1]), pk2(v[2], v[3])}; }
        __syncthreads();
        epi::EpiFF1 E{SS1, HID}; GEMM(epi::EpiFF1, E, X1B, W1T, DFF, DM); }
    SEAM(7);
    if (IN(8)) {
        { epi::EpiRes<true> E{X1B, X2B, SS2}; GEMM(epi::EpiRes<true>, E, HID, W2T, DM, DFF); }
        { epi::EpiGateTmp E{nullptr, (bf16*)(ws + WS_GATE)}; GEMM(epi::EpiGateTmp, E, PB, WP, DM, PLE); }
    }
    SEAM(8);
    if (IN(9)) {
        bf16* PPB = (bf16*)(ws + WS_GATE);
        { epi::EpiPleFinal E{X2B, SS2, PPB, out, SS3, norm_final, (unsigned*)(ws + WS_PCNT)}; GEMM(epi::EpiPleFinal, E, X2B, WG, DM, DM); }
    }
    if (lo < 0) cg::this_grid().sync();
#ifdef DBG_K
    if (hi == DBG_K + 1) {
        cg::this_grid().sync();
        const size_t N16 = (size_t)MTOK * DM;
        for (size_t i = (size_t)bid * 512 + tid; i < N16; i += (size_t)G * 512) {
            float v = 0.f; const size_t h = i & (N16 / 2 - 1);
            if (DBG_K == 0) v = bf2f(XB[i]) + R0[i & 8191] + bf2f(WIN[i]) + bf2f(WA[i & 2097151]) + bf2f(WB[i & 2097151]) + bf2f(WO[i & 4194303]) + LB[i & 1023];
            if (DBG_K == 1) v = bf2f(SEG16[i]) + bf2f(SEG16[i + N16]) + bf2f(SEG16[i + 2 * N16]) + bf2f(GATE[i]) + bf2f(GATE[i + N16]) + LOGF[h] + STATS[i & 16383];
            if (DBG_K == 2) v = bf2f(Qb[h]) + INTRA[h] + bf2f(UCT[i]) + LAM[i & 131071];
            if (DBG_K == 3) v = bf2f(UCT[i]) + bf2f(UBUF[h]);
            if (DBG_K == 4) v = bf2f(OA[h]);
            if (DBG_K == 5) v = bf2f(MERGED[i]);
            if (DBG_K == 7) v = bf2f(HID[i]) + bf2f(HID[i + N16]) + bf2f(HID[i + 2 * N16]) + bf2f(HID[i + 3 * N16]);
            out[i] = v;
        }
    }
#endif
#undef IN
#undef SEAM
#undef GEMM
}

#ifndef N_LAUNCHES
#define N_LAUNCHES 1
#endif
extern "C" void kernel_launch(void* const* d_in, const int* in_sizes, int n_in, void* d_out, int out_size, void* d_ws, size_t ws_size, hipStream_t stream) {
    static int grid = 0;
    if (grid == 0) {
        if (n_in != 20 || out_size != MTOK * DM || ws_size < WS_END) { fprintf(stderr, "kernel_launch: unexpected shapes (n_in %d, out %d, ws %zu)\n", n_in, out_size, ws_size); grid = -1; return; }
        int dev = 0, cus = 0, per_cu = 0;
        hipGetDevice(&dev); hipDeviceGetAttribute(&cus, hipDeviceAttributeMultiprocessorCount, dev);
        if (hipFuncSetAttribute((const void*)fwd_kernel, hipFuncAttributeMaxDynamicSharedMemorySize, LDS_BYTES) != hipSuccess) { fprintf(stderr, "kernel_launch: hipFuncSetAttribute failed\n"); grid = -1; return; }
        hipOccupancyMaxActiveBlocksPerMultiprocessor(&per_cu, (const void*)fwd_kernel, 512, LDS_BYTES);
        if (per_cu < 1) { fprintf(stderr, "kernel_launch: occupancy query says %d blocks per CU\n", per_cu); per_cu = 1; }
        (void)hipGetLastError();
        grid = cus;
    }
    if (grid < 0) return;
    Args a{};
    for (int i = 0; i < 20; ++i) a.in[i] = (const float*)d_in[i];
    a.out = (float*)d_out; a.ws = (unsigned char*)d_ws;
    if (hipMemsetAsync((char*)d_ws + WS_BAR, 0, WS_BAR_BYTES, stream) != hipSuccess) { fprintf(stderr, "kernel_launch: memset failed\n"); return; }
    if (N_LAUNCHES == 1) {
        a.ph_lo = 0; a.ph_hi = NPH;
#ifdef DBG_K
        a.ph_hi = DBG_K + 1;
#endif
        void* kargs[] = {&a};
        hipError_t e = hipLaunchCooperativeKernel((const void*)fwd_kernel, dim3(grid), dim3(512), kargs, LDS_BYTES, stream);
        if (e != hipSuccess) fprintf(stderr, "kernel_launch: cooperative launch failed: %s (grid %d)\n", hipGetErrorString(e), grid);
    } else {
        for (int ph = 0; ph < NPH; ++ph) { a.ph_lo = ph; a.ph_hi = ph + 1; hipLaunchKernelGGL(fwd_kernel, dim3(grid), dim3(512), LDS_BYTES, stream, a); }
    }
}
```

```cpp
#include <hip/hip_runtime.h>
#include <hip/hip_cooperative_groups.h>
#include <cstdio>
#include <cstdint>
namespace cg = cooperative_groups;
namespace pg8 {
#define PG8_LAS __attribute__((address_space(3)))
typedef unsigned short bf16_t;
typedef short bf16x8 __attribute__((ext_vector_type(8)));
typedef float f32x4 __attribute__((ext_vector_type(4)));
typedef unsigned u32x4 __attribute__((ext_vector_type(4)));
constexpr int BM = 256, BK = 64, HALF = 128, HTB = HALF * BK * 2  , STAGE_BYTES = 8 * HTB, NXCD = 8, WGM = 8;

__host__ __device__ __forceinline__ int lds_byte(int r, int c) { const int st = (r >> 4) * 2 + (c >> 5), rr = r & 15, cc = c & 31, ob = rr * 64 + cc * 2; return st * 1024 + (ob ^ (((ob >> 9) & 1) << 5)); }
__host__ __device__ __forceinline__ void stage_rc(int b, int& R, int& C) { const int st = b / 1024, sb = b % 1024, swz = sb ^ (((sb >> 9) & 1) << 5); R = (st >> 1) * 16 + swz / 64; C = (st & 1) * 32 + (swz % 64) / 2; }
__host__ __device__ __forceinline__ int perm32(int rho) { const int n = rho >> 4, i = rho & 15; return 8 * (i >> 2) + 4 * n + (i & 3); }

struct Unit { int pm, pn; };
struct Gemm { const bf16_t* A; const bf16_t* Bt; int M, N, K; };

struct StaticOrder {
    int nM, nN, nwg, G, c;
    __host__ __device__ void init(int M, int N, int G_, int c_) { nM = M / BM; nN = N / BM; nwg = nM * nN; G = G_; c = c_; }
    __host__ __device__ bool next(int i, Unit& u) const {
        const long L = (long)i * G + c; if (L >= nwg) return false;
        int wgid = (int)L; { const int q = nwg / NXCD, r = nwg % NXCD, xcd = wgid % NXCD, off = wgid / NXCD; wgid = (xcd < r ? xcd * (q + 1) : r * (q + 1) + (xcd - r) * q) + off; }
        const int nig = WGM * nN, gid = wgid / nig, fm = gid * WGM, gsz = (nM - fm) < WGM ? (nM - fm) : WGM;
        u.pm = fm + ((wgid % nig) % gsz); u.pn = (wgid % nig) / gsz; return true;
    }
    __device__ __forceinline__ void a_ready(const Unit&) const {}
    __device__ __forceinline__ void done(const Unit&) const {}
};
__device__ __forceinline__ unsigned cvt_pk_bf16(float lo, float hi) { unsigned r; asm volatile("v_cvt_pk_bf16_f32 %0, %1, %2" : "=v"(r) : "v"(lo), "v"(hi)); return r; }
typedef float f32x2 __attribute__((ext_vector_type(2)));
template <class Epi, class Sched, bool ALIGN_EPI = false, bool SP2 = false>
__device__ __forceinline__ void gemm_phase(PG8_LAS unsigned char* lds, const Gemm g, const Sched& S, const Epi& E) {
    const int tid = threadIdx.x, wid = __builtin_amdgcn_readfirstlane(tid >> 6), lane = tid & 63, wr = wid >> 2, wc = wid & 3, fr = lane & 15, fq = lane >> 4;
    const int K = g.K, nt = K / BK;
    unsigned voffA[2], voffB[2];
#pragma unroll
    for (int i = 0; i < 2; ++i) { int R, C; stage_rc(tid * 16 + i * 8192, R, C); const int Rb = Epi::PERM ? ((R & ~31) + perm32(R & 31)) : R;
        voffA[i] = (unsigned)(R * K + C) * 2u; voffB[i] = (unsigned)(Rb * K + C) * 2u; }
    const size_t kstep = (size_t)(BK * 2);
    const size_t hstep = (size_t)HALF * K * 2;
    const size_t tstep = 2 * hstep;
    const unsigned ldsw = (unsigned)wid * 1024u;
    const int aoff = lds_byte(wr * 64 + fr, fq * 8), boff = lds_byte(wc * 32 + fr, fq * 8);
#define PG8_SA(b, h) (((b) * 2 + (h)) * HTB)
#define PG8_SB(b, h) ((4 + (b) * 2 + (h)) * HTB)
#define PG8_STAGE(bufoff, gbase, voff) do { _Pragma("unroll") for (int _i = 0; _i < 2; ++_i) \
        __builtin_amdgcn_global_load_lds((const unsigned*)((const char*)(gbase) + (voff)[_i]), (PG8_LAS unsigned*)(lds + (bufoff) + ldsw + _i * 8192), 16, 0, 0); } while (0)
#define PG8_LDA(dst, b, h) do { _Pragma("unroll") for (int m = 0; m < 4; ++m) _Pragma("unroll") for (int k = 0; k < 2; ++k) dst[m][k] = *(const PG8_LAS bf16x8*)(lds + PG8_SA(b, h) + aoff + m * 2048 + k * 1024); } while (0)
#define PG8_LDB(dst, b, h) do { _Pragma("unroll") for (int n = 0; n < 2; ++n) _Pragma("unroll") for (int k = 0; k < 2; ++k) dst[n][k] = *(const PG8_LAS bf16x8*)(lds + PG8_SB(b, h) + boff + n * 2048 + k * 1024); } while (0)
#define PG8_MMA(ai, bj, At, Bt) do { __builtin_amdgcn_s_setprio(1); _Pragma("unroll") for (int m = 0; m < 4; ++m) _Pragma("unroll") for (int n = 0; n < 2; ++n) _Pragma("unroll") for (int k = 0; k < 2; ++k) \
        acc[ai][bj][m][n] = __builtin_amdgcn_mfma_f32_16x16x32_bf16(Bt[n][k], At[m][k], acc[ai][bj][m][n], 0, 0, 0); __builtin_amdgcn_s_setprio(0); } while (0)
#define PG8_WAIT_V(n) asm volatile("s_waitcnt vmcnt(" #n ")" ::: "memory")
#define PG8_WAIT_L(n) asm volatile("s_waitcnt lgkmcnt(" #n ")" ::: "memory")
#define PG8_BAR __builtin_amdgcn_s_barrier()
#define PG8_SCHED __builtin_amdgcn_sched_barrier(0)
    Unit cur, nxt; int ui = 0;
    if (!S.next(0, cur)) return;
    f32x4 acc[2][2][4][2];
#pragma unroll
    for (int a = 0; a < 2; ++a)
#pragma unroll
        for (int b = 0; b < 2; ++b)
#pragma unroll
            for (int m = 0; m < 4; ++m)
#pragma unroll
                for (int n = 0; n < 2; ++n) acc[a][b][m][n] = (f32x4){0.f, 0.f, 0.f, 0.f};
    bf16x8 At[4][2], B0[2][2], B1[2][2];
    const char* cA = (const char*)g.A + (size_t)cur.pm * tstep; const char* cB = (const char*)g.Bt + (size_t)cur.pn * tstep;
    S.a_ready(cur);
    if constexpr (SP2) {
        PG8_STAGE(PG8_SB(0, 0), cB, voffB); PG8_STAGE(PG8_SB(0, 1), cB + hstep, voffB); PG8_STAGE(PG8_SA(0, 0), cA, voffA); PG8_STAGE(PG8_SA(0, 1), cA + hstep, voffA);
        if (wr == 1) PG8_BAR;
        PG8_WAIT_V(2); PG8_BAR;
        PG8_STAGE(PG8_SB(1, 0), cB + kstep, voffB); PG8_STAGE(PG8_SA(1, 0), cA + kstep, voffA); PG8_STAGE(PG8_SB(1, 1), cB + hstep + kstep, voffB);
        PG8_WAIT_V(6); PG8_BAR;
    } else {
        PG8_STAGE(PG8_SB(0, 0), cB, voffB); PG8_STAGE(PG8_SA(0, 0), cA, voffA); PG8_STAGE(PG8_SB(0, 1), cB + hstep, voffB); PG8_STAGE(PG8_SA(0, 1), cA + hstep, voffA);
        if (wr == 1) PG8_BAR;
        PG8_WAIT_V(4); PG8_BAR;
        PG8_STAGE(PG8_SB(1, 0), cB + kstep, voffB); PG8_STAGE(PG8_SA(1, 0), cA + kstep, voffA); PG8_STAGE(PG8_SB(1, 1), cB + hstep + kstep, voffB);
        PG8_WAIT_V(6); PG8_BAR;
    }
    for (;;) {
        const bool has_next = S.next(ui + 1, nxt);
        const char* nA = has_next ? (const char*)g.A + (size_t)nxt.pm * tstep : cA; const char* nB = has_next ? (const char*)g.Bt + (size_t)nxt.pn * tstep : cB;
        for (int t = 0; t < nt; t += 2) {
            const bool last = (t == nt - 2);
            const char* a1 = cA + (size_t)(t + 1) * kstep;
            const char* a2 = last ? nA : cA + (size_t)(t + 2) * kstep; const char* b2 = last ? nB : cB + (size_t)(t + 2) * kstep;
            const char* a3 = a2 + kstep; const char* b3 = b2 + kstep;
            if (last && has_next) S.a_ready(nxt);
            if constexpr (SP2) {
            PG8_LDB(B0, 0, 0); PG8_LDB(B1, 0, 1); PG8_SCHED; PG8_LDA(At, 0, 0); PG8_STAGE(PG8_SA(1, 1), a1 + hstep, voffA);
            PG8_WAIT_V(8); PG8_WAIT_L(0); PG8_BAR; PG8_MMA(0, 0, At, B0); PG8_MMA(0, 1, At, B1); PG8_BAR; PG8_SCHED;
            PG8_LDA(At, 0, 1); PG8_STAGE(PG8_SB(0, 0), b2, voffB); PG8_STAGE(PG8_SB(0, 1), b2 + hstep, voffB); PG8_STAGE(PG8_SA(0, 0), a2, voffA);
            PG8_WAIT_V(8); PG8_WAIT_L(0); PG8_BAR; PG8_MMA(1, 0, At, B0); PG8_MMA(1, 1, At, B1); PG8_BAR; PG8_SCHED;
            PG8_LDB(B0, 1, 0); PG8_LDB(B1, 1, 1); PG8_SCHED; PG8_LDA(At, 1, 0); PG8_STAGE(PG8_SA(0, 1), a2 + hstep, voffA);
            PG8_WAIT_V(8); PG8_WAIT_L(0); PG8_BAR; PG8_MMA(0, 0, At, B0); PG8_MMA(0, 1, At, B1); PG8_BAR; PG8_SCHED;
            PG8_LDA(At, 1, 1); PG8_STAGE(PG8_SB(1, 0), b3, voffB); PG8_STAGE(PG8_SB(1, 1), b3 + hstep, voffB); PG8_STAGE(PG8_SA(1, 0), a3, voffA);
            PG8_WAIT_V(8); PG8_WAIT_L(0); PG8_BAR; PG8_MMA(1, 0, At, B0); PG8_MMA(1, 1, At, B1); PG8_BAR; PG8_SCHED;
            } else {
            PG8_LDB(B0, 0, 0); PG8_SCHED; PG8_LDA(At, 0, 0); PG8_STAGE(PG8_SA(1, 1), a1 + hstep, voffA);
            PG8_WAIT_L(8); PG8_BAR; PG8_WAIT_L(0); PG8_MMA(0, 0, At, B0); PG8_BAR; PG8_SCHED;
            PG8_LDB(B1, 0, 1); PG8_STAGE(PG8_SB(0, 0), b2, voffB);
            PG8_BAR; PG8_WAIT_L(0); PG8_MMA(0, 1, At, B1); PG8_BAR;
            PG8_LDA(At, 0, 1); PG8_STAGE(PG8_SA(0, 0), a2, voffA);
            PG8_BAR; PG8_WAIT_L(0); PG8_MMA(1, 0, At, B0); PG8_BAR; PG8_SCHED;
            PG8_STAGE(PG8_SB(0, 1), b2 + hstep, voffB);
            PG8_WAIT_V(6); PG8_BAR; PG8_MMA(1, 1, At, B1); PG8_BAR;
            PG8_LDB(B0, 1, 0); PG8_SCHED; PG8_LDA(At, 1, 0); PG8_STAGE(PG8_SA(0, 1), a2 + hstep, voffA);
            PG8_WAIT_L(8); PG8_BAR; PG8_WAIT_L(0); PG8_MMA(0, 0, At, B0); PG8_BAR; PG8_SCHED;
            PG8_LDB(B1, 1, 1); PG8_STAGE(PG8_SB(1, 0), b3, voffB);
            PG8_BAR; PG8_WAIT_L(0); PG8_MMA(0, 1, At, B1); PG8_BAR;
            PG8_LDA(At, 1, 1); PG8_STAGE(PG8_SA(1, 0), a3, voffA);
            PG8_BAR; PG8_WAIT_L(0); PG8_MMA(1, 0, At, B0); PG8_BAR; PG8_SCHED;
            PG8_STAGE(PG8_SB(1, 1), b3 + hstep, voffB);
            PG8_WAIT_V(6); PG8_BAR; PG8_MMA(1, 1, At, B1); PG8_BAR;
            }
        }
        if constexpr (ALIGN_EPI) { if (wr == 0) PG8_BAR; }
        if constexpr (!Epi::AFTER_DRAIN) { E(acc, cur, wr, wc, fr, fq); S.done(cur); }
        if (!has_next) break;
#pragma unroll
        for (int a = 0; a < 2; ++a)
#pragma unroll
            for (int b = 0; b < 2; ++b)
#pragma unroll
                for (int m = 0; m < 4; ++m)
#pragma unroll
                    for (int n = 0; n < 2; ++n) acc[a][b][m][n] = (f32x4){0.f, 0.f, 0.f, 0.f};
        cur = nxt; cA = nA; cB = nB; ++ui;
        if constexpr (ALIGN_EPI) { if (wr == 1) PG8_BAR; }
    }
    PG8_WAIT_V(0);
    if constexpr (!ALIGN_EPI) { if (wr == 0) PG8_BAR; }
    PG8_BAR;
    if constexpr (Epi::AFTER_DRAIN) { E.fused(acc, cur, wr, wc, fr, fq, lds, wid, lane); S.done(cur); }
#undef PG8_SA
#undef PG8_SB
#undef PG8_STAGE
#undef PG8_LDA
#undef PG8_LDB
#undef PG8_MMA
#undef PG8_WAIT_V
#undef PG8_WAIT_L
#undef PG8_BAR
#undef PG8_SCHED
}
}

constexpr int MTOK = 8192, DM = 2048, SEQ = 2048, HW = 1024, NIN = 10240, DFF = 8192, PLE = 256;
constexpr float EPS = 1e-6f;
constexpr size_t MiB = 1u << 20;
constexpr size_t WS_SEG16 = 0;
constexpr size_t WS_LOGF = 96 * MiB;
constexpr size_t WS_HID = 0;
constexpr size_t WS_GATE = 128 * MiB;
constexpr size_t WS_X1 = 128 * MiB;
constexpr size_t WS_WIN = 192 * MiB;
constexpr size_t WS_XB = 232 * MiB;
constexpr size_t WS_UCT = 192 * MiB;
constexpr size_t WS_OA = 16 * MiB, WS_UB = 32 * MiB;
constexpr size_t WS_MERGED = 192 * MiB;
constexpr size_t WS_X1B = 232 * MiB;
constexpr size_t WS_W2T = 192 * MiB;
constexpr size_t WS_X2B = 232 * MiB;
constexpr size_t WS_WA = 264 * MiB, WS_WB = 268 * MiB, WS_WO = 272 * MiB;
constexpr size_t WS_WG = 264 * MiB, WS_WP = 272 * MiB, WS_PB = 273 * MiB;
constexpr size_t WS_INTRA = 280 * MiB;
constexpr size_t WS_W1T = 280 * MiB;
constexpr size_t WS_SMALL = 312 * MiB;
constexpr size_t WS_R0 = WS_SMALL, WS_STATS = WS_SMALL + 32768, WS_SS1 = WS_SMALL + 98304, WS_SS2 = WS_SMALL + 131072, WS_SS3 = WS_SMALL + 163840,
                 WS_LB = WS_SMALL + 196608, WS_LAM = WS_SMALL + 262144, WS_BAR = WS_SMALL + 819200, WS_BAR_BYTES = 32768, WS_PCNT = WS_BAR + 16384, WS_END = 313 * MiB;
constexpr int LDS_BYTES = 147456;

#define LAS __attribute__((address_space(3)))
typedef unsigned short bf16;
typedef unsigned v4u __attribute__((ext_vector_type(4)));
typedef unsigned v2u __attribute__((ext_vector_type(2)));
typedef float f32x4 __attribute__((ext_vector_type(4)));
typedef short bf16x8 __attribute__((ext_vector_type(8)));
#define LDS_WAIT() asm volatile("s_waitcnt lgkmcnt(0)" ::: "memory")

typedef float f32x2_t __attribute__((ext_vector_type(2))); typedef __bf16 bf16x2_t __attribute__((ext_vector_type(2)));
__device__ __forceinline__ unsigned pk2(float lo, float hi) { f32x2_t v = {lo, hi}; bf16x2_t b = __builtin_convertvector(v, bf16x2_t); return __builtin_bit_cast(unsigned, b); }
__device__ __forceinline__ float bflo(unsigned w) { return __uint_as_float(w << 16); }
__device__ __forceinline__ float bfhi(unsigned w) { return __uint_as_float(w & 0xffff0000u); }
__device__ __forceinline__ float bf2f(bf16 b) { return __uint_as_float((unsigned)b << 16); }
__device__ __forceinline__ bf16 f2bf(float f) { return (bf16)(pk2(f, 0.f) & 0xffffu); }
__device__ __forceinline__ float sigmoidf_(float v) { return __builtin_amdgcn_rcpf(1.0f + __expf(-v)); }
typedef float f32x2 __attribute__((ext_vector_type(2)));
typedef _Float16 h16x2 __attribute__((ext_vector_type(2)));
typedef _Float16 h16x8 __attribute__((ext_vector_type(8)));
__device__ __forceinline__ unsigned pkh2(float lo, float hi) { f32x2 v_ = {lo, hi}; return __builtin_bit_cast(unsigned, __builtin_convertvector(v_, h16x2)); }
__device__ __forceinline__ f32x2 gelu_pk(f32x2 v) {
    const f32x2 av = __builtin_elementwise_abs(v), d = av * 0.2316418882f + 1.0f;
    f32x2 t; t.x = __builtin_amdgcn_rcpf(d.x); t.y = __builtin_amdgcn_rcpf(d.y);
    f32x2 q = t * 0.5307027145f + (-0.7265760135f); q = q * t + 0.7107068705f; q = q * t + (-0.142248368f); q = q * t + 0.127414796f; q = q * t;
    const f32x2 s = (v * v) * (-0.72134752044f);
    f32x2 e; e.x = __builtin_amdgcn_exp2f(s.x); e.y = __builtin_amdgcn_exp2f(s.y);
    const f32x2 m = v * (q * e), r = v - m;
    f32x2 o; o.x = v.x < 0.f ? m.x : r.x; o.y = v.y < 0.f ? m.y : r.y; return o;
}
__device__ __forceinline__ float siluf_(float v) { return v * sigmoidf_(v); }
#define SIG4(V_) (f32x4){sigmoidf_((V_)[0]), sigmoidf_((V_)[1]), sigmoidf_((V_)[2]), sigmoidf_((V_)[3])}
__device__ __forceinline__ float wave_sum(float v) {
#pragma unroll
    for (int o = 1; o < 64; o <<= 1) v += __shfl_xor(v, o);
    return v;
}

namespace epi {
using pg8::Unit;
struct EpiIn {
    static constexpr bool PERM = true, AFTER_DRAIN = false;
    const float* r0; const float* lb; bf16* seg16; bf16* gate; float* lgf; float* stats;
    __device__ __forceinline__ void operator()(const f32x4 (&acc)[2][2][4][2], const Unit& u, int wr, int wc, int fr, int fq) const {
        const int pn = u.pn; int mode, ld, colt; bf16* base;
        if (pn < 24) { const int s = pn >> 2; colt = (pn & 3) * 256; ld = HW; base = seg16 + (size_t)s * ((size_t)MTOK * HW); mode = (s == 1) ? 1 : (s == 5) ? 4 : 2; }
        else { const int s = (pn - 24) >> 3; colt = ((pn - 24) & 7) * 256; ld = DM; base = gate + (size_t)s * ((size_t)MTOK * DM); mode = 2; }
        const int row0 = u.pm * 256 + wr * 64 + fr, col0 = colt + wc * 32 + 8 * fq;
        float rsv[8];
#pragma unroll
        for (int it = 0; it < 8; ++it) rsv[it] = r0[row0 + (it >> 2) * 128 + (it & 3) * 16];
        f32x4 lbv[2][2] = {{{0.f, 0.f, 0.f, 0.f}, {0.f, 0.f, 0.f, 0.f}}, {{0.f, 0.f, 0.f, 0.f}, {0.f, 0.f, 0.f, 0.f}}};
        if (mode == 1) { lbv[0][0] = *(const f32x4*)(lb + col0); lbv[0][1] = *(const f32x4*)(lb + col0 + 4); lbv[1][0] = *(const f32x4*)(lb + col0 + 128); lbv[1][1] = *(const f32x4*)(lb + col0 + 132); }
#pragma unroll
        for (int ai = 0; ai < 2; ++ai)
#pragma unroll
            for (int m = 0; m < 4; ++m) {
                const int row = row0 + ai * 128 + m * 16; const float rs = rsv[ai * 4 + m]; float s1 = 0.f, s2 = 0.f;
#pragma unroll
                for (int bj = 0; bj < 2; ++bj) {
                    const int c = col0 + bj * 128; float v[8];
#pragma unroll
                    for (int j = 0; j < 4; ++j) { v[j] = acc[ai][bj][m][0][j] * rs; v[4 + j] = acc[ai][bj][m][1][j] * rs; }
                    if (mode == 0) {
#pragma unroll
                        for (int j = 0; j < 8; ++j) v[j] = v[j] * sigmoidf_(v[j]);
                    } else if (mode == 1) {
                        const f32x4 l0 = lbv[bj][0], l1 = lbv[bj][1]; float lg[8];
#pragma unroll
                        for (int j = 0; j < 8; ++j) { const float l = j < 4 ? l0[j] : l1[j - 4]; const float sg = sigmoidf_(v[j]); const float f = l + (1.0f - l) * sg; lg[j] = logf(f); }
                        *(v4u*)((unsigned short*)lgf + (size_t)row * HW + c) = (v4u){pkh2(lg[0], lg[1]), pkh2(lg[2], lg[3]), pkh2(lg[4], lg[5]), pkh2(lg[6], lg[7])};
                        continue;
                    } else if (mode == 3) {
#pragma unroll
                        for (int j = 0; j < 8; j += 2) { const f32x2 g2 = gelu_pk((f32x2){v[j], v[j + 1]}); v[j] = g2.x; v[j + 1] = g2.y; }
                    } else if (mode == 4) {
#pragma unroll
                        for (int j = 0; j < 8; j += 2) { const f32x2 g2 = gelu_pk((f32x2){v[j], v[j + 1]}); v[j] = g2.x; v[j + 1] = g2.y; s1 += g2.x + g2.y; s2 += g2.x * g2.x + g2.y * g2.y; }
                    } else if (mode == 5) {
#pragma unroll
                        for (int j = 0; j < 8; ++j) v[j] = sigmoidf_(v[j]);
                    }
                    v4u w; w.x = pk2(v[0], v[1]); w.y = pk2(v[2], v[3]); w.z = pk2(v[4], v[5]); w.w = pk2(v[6], v[7]);
                    *(v4u*)(base + (size_t)row * ld + c) = w;
                }
                if (mode == 4) {
                    s1 += __shfl_xor(s1, 16); s1 += __shfl_xor(s1, 32); s2 += __shfl_xor(s2, 16); s2 += __shfl_xor(s2, 32);
                    if (fq == 0) { unsafeAtomicAdd(stats + 2 * row, s1); unsafeAtomicAdd(stats + 2 * row + 1, s2); }
                }
                asm volatile("" ::: "memory");
            }
    }
};
#define EPI_OFF(it) ((size_t)(row0 + ((it) >> 2) * 128 + ((it) & 3) * 16) * DM + col0)
#define UNPK_LO(PK_) (f32x4){bflo((PK_).x), bfhi((PK_).x), bflo((PK_).y), bfhi((PK_).y)}
#define UNPK_HI(PK_) (f32x4){bflo((PK_).z), bfhi((PK_).z), bflo((PK_).w), bfhi((PK_).w)}
struct EpiGateTmp {
    static constexpr bool PERM = true, AFTER_DRAIN = false;
    const bf16* gate; bf16* tmp;
    __device__ __forceinline__ void operator()(const f32x4 (&acc)[2][2][4][2], const Unit& u, int wr, int wc, int fr, int fq) const {
        const int row0 = u.pm * 256 + wr * 64 + fr, col0 = u.pn * 256 + wc * 32 + 8 * fq;
        if (!gate) {
#pragma unroll
            for (int it = 0; it < 8; ++it) { const size_t off = EPI_OFF(it);
#pragma unroll
                for (int bj = 0; bj < 2; ++bj) { const f32x4 a0 = acc[it >> 2][bj][it & 3][0], a1 = acc[it >> 2][bj][it & 3][1];
                    v4u w; w.x = pk2(a0[0], a0[1]); w.y = pk2(a0[2], a0[3]); w.z = pk2(a1[0], a1[1]); w.w = pk2(a1[2], a1[3]);
                    *(v4u*)(tmp + off + bj * 128) = w; } }
            return;
        }
        v4u gc[2], gn[2];
        gc[0] = __builtin_nontemporal_load((const v4u*)(gate + EPI_OFF(0))); gc[1] = __builtin_nontemporal_load((const v4u*)(gate + EPI_OFF(0) + 128));
#pragma unroll
        for (int it = 0; it < 8; ++it) { const size_t off = EPI_OFF(it);
            if (it < 7) { gn[0] = __builtin_nontemporal_load((const v4u*)(gate + EPI_OFF(it + 1))); gn[1] = __builtin_nontemporal_load((const v4u*)(gate + EPI_OFF(it + 1) + 128)); }
#pragma unroll
            for (int bj = 0; bj < 2; ++bj) { const v4u g = gc[bj];
                const f32x4 gl = UNPK_LO(g), gh = UNPK_HI(g); const f32x4 a0 = acc[it >> 2][bj][it & 3][0] * SIG4(gl), a1 = acc[it >> 2][bj][it & 3][1] * SIG4(gh);
                v4u w; w.x = pk2(a0[0], a0[1]); w.y = pk2(a0[2], a0[3]); w.z = pk2(a1[0], a1[1]); w.w = pk2(a1[2], a1[3]);
                *(v4u*)(tmp + off + bj * 128) = w; }
            gc[0] = gn[0]; gc[1] = gn[1];
            asm volatile("" ::: "memory"); }
    }
};
struct EpiMerge {
    static constexpr bool PERM = true, AFTER_DRAIN = false;
    const bf16* gate; bf16* io;
    __device__ __forceinline__ void operator()(const f32x4 (&acc)[2][2][4][2], const Unit& u, int wr, int wc, int fr, int fq) const {
        const int row0 = u.pm * 256 + wr * 64 + fr, col0 = u.pn * 256 + wc * 32 + 8 * fq;
        v4u gc[2], gn[2], tc[2], tn[2];
#define EPI_LD(G, T, it) do { const size_t o_ = EPI_OFF(it); G[0] = __builtin_nontemporal_load((const v4u*)(gate + o_)); G[1] = __builtin_nontemporal_load((const v4u*)(gate + o_ + 128)); T[0] = *(const v4u*)(io + o_); T[1] = *(const v4u*)(io + o_ + 128); } while (0)
        EPI_LD(gc, tc, 0);
#pragma unroll
        for (int it = 0; it < 8; ++it) { const size_t off = EPI_OFF(it);
            if (it < 7) EPI_LD(gn, tn, it + 1);
#pragma unroll
            for (int bj = 0; bj < 2; ++bj) { const v4u g = gc[bj], t = tc[bj];
                const f32x4 gl = UNPK_LO(g), gh = UNPK_HI(g); const f32x4 a0 = UNPK_LO(t) + acc[it >> 2][bj][it & 3][0] * SIG4(gl), a1 = UNPK_HI(t) + acc[it >> 2][bj][it & 3][1] * SIG4(gh);
                v4u w; w.x = pk2(a0[0], a0[1]); w.y = pk2(a0[2], a0[3]); w.z = pk2(a1[0], a1[1]); w.w = pk2(a1[2], a1[3]);
                *(v4u*)(io + off + bj * 128) = w; }
            gc[0] = gn[0]; gc[1] = gn[1]; tc[0] = tn[0]; tc[1] = tn[1];
            asm volatile("" ::: "memory"); }
#undef EPI_LD
    }
};
template <bool BASEB> struct EpiRes {
    static constexpr bool PERM = true, AFTER_DRAIN = false;
    const void* basep; bf16* xb; float* ss;
    __device__ __forceinline__ void operator()(const f32x4 (&acc)[2][2][4][2], const Unit& u, int wr, int wc, int fr, int fq) const {
        const int row0 = u.pm * 256 + wr * 64 + fr, col0 = u.pn * 256 + wc * 32 + 8 * fq;
        f32x4 bc[4], bn[4];
#define EPI_LD(B, it) do { const size_t o_ = EPI_OFF(it); \
            if constexpr (BASEB) { const bf16* b_ = (const bf16*)basep; const v4u w0 = *(const v4u*)(b_ + o_), w1 = *(const v4u*)(b_ + o_ + 128); B[0] = UNPK_LO(w0); B[1] = UNPK_HI(w0); B[2] = UNPK_LO(w1); B[3] = UNPK_HI(w1); } \
            else { const float* b_ = (const float*)basep; B[0] = __builtin_nontemporal_load((const f32x4*)(b_ + o_)); B[1] = __builtin_nontemporal_load((const f32x4*)(b_ + o_ + 4)); \
                   B[2] = __builtin_nontemporal_load((const f32x4*)(b_ + o_ + 128)); B[3] = __builtin_nontemporal_load((const f32x4*)(b_ + o_ + 132)); } } while (0)
        EPI_LD(bc, 0);
#pragma unroll
        for (int it = 0; it < 8; ++it) { const size_t off = EPI_OFF(it); const int row = row0 + (it >> 2) * 128 + (it & 3) * 16; float s = 0.f;
            if (it < 7) EPI_LD(bn, it + 1);
#pragma unroll
            for (int bj = 0; bj < 2; ++bj) {
                const f32x4 a0 = bc[2 * bj] + acc[it >> 2][bj][it & 3][0], a1 = bc[2 * bj + 1] + acc[it >> 2][bj][it & 3][1];
                s += (a0[0] * a0[0] + a0[1] * a0[1]) + (a0[2] * a0[2] + a0[3] * a0[3]) + (a1[0] * a1[0] + a1[1] * a1[1]) + (a1[2] * a1[2] + a1[3] * a1[3]);
                v4u w; w.x = pk2(a0[0], a0[1]); w.y = pk2(a0[2], a0[3]); w.z = pk2(a1[0], a1[1]); w.w = pk2(a1[2], a1[3]);
                *(v4u*)(xb + off + bj * 128) = w; }
            s += __shfl_xor(s, 16); s += __shfl_xor(s, 32);
            if (fq == 0) unsafeAtomicAdd(ss + row, s);
            bc[0] = bn[0]; bc[1] = bn[1]; bc[2] = bn[2]; bc[3] = bn[3];
            asm volatile("" ::: "memory"); }
#undef EPI_LD
    }
};
struct EpiFF1 {
    static constexpr bool PERM = true, AFTER_DRAIN = false;
    const float* ss; bf16* out;
    __device__ __forceinline__ void operator()(const f32x4 (&acc)[2][2][4][2], const Unit& u, int wr, int wc, int fr, int fq) const {
        const int row0 = u.pm * 256 + wr * 64 + fr, col0 = u.pn * 256 + wc * 32 + 8 * fq;
        float rsv[8];
#pragma unroll
        for (int it = 0; it < 8; ++it) rsv[it] = ss[row0 + (it >> 2) * 128 + (it & 3) * 16];
#pragma unroll
        for (int it = 0; it < 8; ++it) { const int row = row0 + (it >> 2) * 128 + (it & 3) * 16; const float rs = rsqrtf(rsv[it] * (1.0f / DM) + EPS);
#pragma unroll
            for (int bj = 0; bj < 2; ++bj) {
                float v[8];
#pragma unroll
                for (int j = 0; j < 4; ++j) { v[j] = fmaxf(acc[it >> 2][bj][it & 3][0][j] * rs, 0.f); v[j] *= v[j]; v[4 + j] = fmaxf(acc[it >> 2][bj][it & 3][1][j] * rs, 0.f); v[4 + j] *= v[4 + j]; }
                v4u w; w.x = pk2(v[0], v[1]); w.y = pk2(v[2], v[3]); w.z = pk2(v[4], v[5]); w.w = pk2(v[6], v[7]);
                *(v4u*)(out + (size_t)row * DFF + col0 + bj * 128) = w; } }
    }
};
struct EpiPleFinal {
    static constexpr bool PERM = true, AFTER_DRAIN = true;
    const bf16* x2; const float* ss2; const bf16* pp; float* out; float* ss3; const float* gfin; unsigned* cnt;
    __device__ __forceinline__ void fused(f32x4 (&acc)[2][2][4][2], const Unit& u, int wr, int wc, int fr, int fq, PG8_LAS unsigned char* lds, int wid, int lane) const {
        const int row0 = u.pm * 256 + wr * 64 + fr, col0 = u.pn * 256 + wc * 32 + 8 * fq;
        float rsv[8];
#pragma unroll
        for (int it = 0; it < 8; ++it) rsv[it] = ss2[row0 + (it >> 2) * 128 + (it & 3) * 16];
        v4u xc[2], xn[2], pc[2], pn[2];
#define EPI_LD(X, P, it) do { const size_t o_ = EPI_OFF(it); X[0] = *(const v4u*)(x2 + o_); X[1] = *(const v4u*)(x2 + o_ + 128); P[0] = *(const v4u*)(pp + o_); P[1] = *(const v4u*)(pp + o_ + 128); } while (0)
        EPI_LD(xc, pc, 0);
#pragma unroll
        for (int it = 0; it < 8; ++it) { const int row = row0 + (it >> 2) * 128 + (it & 3) * 16; const float rs = rsqrtf(rsv[it] * (1.0f / DM) + EPS); float s = 0.f;
            if (it < 7) EPI_LD(xn, pn, it + 1);
#pragma unroll
            for (int bj = 0; bj < 2; ++bj) {
#pragma unroll
                for (int n = 0; n < 2; ++n) { const f32x4 xv = n ? UNPK_HI(xc[bj]) : UNPK_LO(xc[bj]), pv = n ? UNPK_HI(pc[bj]) : UNPK_LO(pc[bj]); f32x4 r;
#pragma unroll
                    for (int j = 0; j < 4; ++j) { r[j] = xv[j] + sigmoidf_(acc[it >> 2][bj][it & 3][n][j] * rs) * pv[j]; s += r[j] * r[j]; }
                    acc[it >> 2][bj][it & 3][n] = r; } }
            s += __shfl_xor(s, 16); s += __shfl_xor(s, 32);
            if (fq == 0) unsafeAtomicAdd(ss3 + row, s);
            xc[0] = xn[0]; xc[1] = xn[1]; pc[0] = pn[0]; pc[1] = pn[1];
            asm volatile("" ::: "memory"); }
#undef EPI_LD
        asm volatile("s_waitcnt vmcnt(0)" ::: "memory");
        __syncthreads();
        if (threadIdx.x == 0) {
            unsigned* c = cnt + 64 * u.pm;
            __hip_atomic_fetch_add(c, 1u, __ATOMIC_RELAXED, __HIP_MEMORY_SCOPE_AGENT);
            unsigned sp = 0;
            while (__hip_atomic_load(c, __ATOMIC_RELAXED, __HIP_MEMORY_SCOPE_AGENT) < 8u) { __builtin_amdgcn_s_sleep(2); if (++sp > (1u << 22)) break; }
        }
        __syncthreads();
        float r3v[8]; f32x4 gf[4];
#pragma unroll
        for (int it = 0; it < 8; ++it) r3v[it] = __hip_atomic_load(ss3 + row0 + (it >> 2) * 128 + (it & 3) * 16, __ATOMIC_RELAXED, __HIP_MEMORY_SCOPE_AGENT);
#pragma unroll
        for (int k = 0; k < 4; ++k) gf[k] = *(const f32x4*)(gfin + col0 + (k >> 1) * 128 + 4 * (k & 1));
#pragma unroll
        for (int it = 0; it < 8; ++it) { const size_t off = EPI_OFF(it); const float r3 = rsqrtf(r3v[it] * (1.0f / DM) + EPS);
#pragma unroll
            for (int bj = 0; bj < 2; ++bj)
#pragma unroll
                for (int n = 0; n < 2; ++n) *(f32x4*)(out + off + bj * 128 + 4 * n) = acc[it >> 2][bj][it & 3][n] * r3 * gf[2 * bj + n]; }
    }
};
}

__device__ __forceinline__ void convert_weight(const float* __restrict__ W, int K, int N, bf16* WT, const float* __restrict__ gain, LAS unsigned char* lds, int gw, int ngw, int wave, int lane) {
    LAS float* scr = (LAS float*)(lds + wave * 16640);
    const int nblk = N / 64, nitems = (K / 64) * nblk;
    const int lrow = lane >> 4, n4 = (lane & 15) * 4, c = lane & 7, nr = lane >> 3;
    f32x4 v[16];
    int it = gw;
    if (it < nitems) { const int kb = it / nblk, nb = it - kb * nblk; const float* src = W + (size_t)(64 * kb + lrow) * N + 64 * nb + n4;
#pragma unroll
        for (int i = 0; i < 16; ++i) v[i] = __builtin_nontemporal_load((const f32x4*)(src + (size_t)(4 * i) * N)); }
    while (it < nitems) {
        const int kb = it / nblk, nb = it - kb * nblk, k0 = 64 * kb, n0 = 64 * nb;
        f32x4 g0 = {1.f, 1.f, 1.f, 1.f}, g1 = {1.f, 1.f, 1.f, 1.f};
        if (gain) { g0 = *(const f32x4*)(gain + k0 + 8 * c); g1 = *(const f32x4*)(gain + k0 + 8 * c + 4); }
#pragma unroll
        for (int i = 0; i < 16; ++i) { LAS float* d = scr + (4 * i + lrow) * 65 + n4; d[0] = v[i][0]; d[1] = v[i][1]; d[2] = v[i][2]; d[3] = v[i][3]; }
        const int nx = it + ngw;
        if (nx < nitems) { const int kb2 = nx / nblk, nb2 = nx - kb2 * nblk; const float* src = W + (size_t)(64 * kb2 + lrow) * N + 64 * nb2 + n4;
#pragma unroll
            for (int i = 0; i < 16; ++i) v[i] = __builtin_nontemporal_load((const f32x4*)(src + (size_t)(4 * i) * N)); }
        LDS_WAIT();
#pragma unroll
        for (int jj = 0; jj < 8; ++jj) { const int n = nr + 8 * jj; const LAS float* s = scr + (8 * c) * 65 + n;
            v4u o; o.x = pk2(s[0 * 65] * g0[0], s[1 * 65] * g0[1]); o.y = pk2(s[2 * 65] * g0[2], s[3 * 65] * g0[3]); o.z = pk2(s[4 * 65] * g1[0], s[5 * 65] * g1[1]); o.w = pk2(s[6 * 65] * g1[2], s[7 * 65] * g1[3]);
            *(v4u*)(WT + (size_t)(n0 + n) * K + k0 + 8 * c) = o; }
        LDS_WAIT();
        it = nx;
    }
}

constexpr int H_G = 0, H_PART = 32768, H_QT = 34816, H_KT = 52224, H_KH = 69632, H_VT = 88064, H_AT = 106496;
constexpr int LDQ = 136, LDS64 = 72;
__device__ __forceinline__ void hgrn_local_phase(int first, int step, LAS unsigned char* lds, bf16* Q, const bf16* Kb, const bf16* V, const float* LOGF, bf16* INTRA, bf16* UCT, float* LAM, int tid) {
    const int lane = tid & 63, w = tid >> 6;
    const int d = tid & 127, part = tid >> 7, t0 = part * 16;
    LAS float* G = (LAS float*)(lds + H_G); LAS float* PART = (LAS float*)(lds + H_PART);
    LAS bf16* QT = (LAS bf16*)(lds + H_QT); LAS bf16* KT = (LAS bf16*)(lds + H_KT); LAS bf16* KH = (LAS bf16*)(lds + H_KH); LAS bf16* VT = (LAS bf16*)(lds + H_VT); LAS bf16* AT = (LAS bf16*)(lds + H_AT);
    h16x8 gr[2]; v4u vr[2]; bf16 qv[16]; float kv[16];
#define HG_LOAD(IT) do { const int c_ = (IT) & 31, h_ = ((IT) >> 5) & 7, b_ = (IT) >> 8; const size_t rb_ = (size_t)b_ * SEQ + c_ * 64; const int cl_ = h_ * 128; \
        _Pragma("unroll") for (int i = 0; i < 2; ++i) { const int idx = i * 512 + tid, t = idx >> 4, c8 = (idx & 15) * 8; gr[i] = *(const h16x8*)((const _Float16*)LOGF + (rb_ + t) * HW + cl_ + c8); } \
        _Pragma("unroll") for (int i = 0; i < 2; ++i) { const int idx = i * 512 + tid, s_ = idx & 63, e0 = (idx >> 6) * 8; vr[i] = *(const v4u*)(V + (rb_ + s_) * HW + cl_ + e0); } \
        _Pragma("unroll") for (int i = 0; i < 16; ++i) { qv[i] = Q[(rb_ + t0 + i) * HW + cl_ + d]; } } while (0)
    if (first < 1024) HG_LOAD(first);
    for (int item = first; item < 1024; item += step) {
    const int c = item & 31, h = (item >> 5) & 7, b = item >> 8;
    const size_t rowbase = (size_t)b * SEQ + c * 64; const int col0 = h * 128;
#pragma unroll
    for (int i = 0; i < 2; ++i) { const int idx = i * 512 + tid, t = idx >> 4, c8 = (idx & 15) * 8; const h16x8 hv = gr[i];
        *(LAS f32x4*)(G + t * 128 + c8) = (f32x4){(float)hv[0], (float)hv[1], (float)hv[2], (float)hv[3]}; *(LAS f32x4*)(G + t * 128 + c8 + 4) = (f32x4){(float)hv[4], (float)hv[5], (float)hv[6], (float)hv[7]}; }
#pragma unroll
    for (int i = 0; i < 2; ++i) { const int idx = i * 512 + tid, s = idx & 63, e0 = (idx >> 6) * 8; const v4u x = vr[i];
        VT[(e0 + 0) * LDS64 + s] = (bf16)(x.x & 0xffff); VT[(e0 + 1) * LDS64 + s] = (bf16)(x.x >> 16); VT[(e0 + 2) * LDS64 + s] = (bf16)(x.y & 0xffff); VT[(e0 + 3) * LDS64 + s] = (bf16)(x.y >> 16);
        VT[(e0 + 4) * LDS64 + s] = (bf16)(x.z & 0xffff); VT[(e0 + 5) * LDS64 + s] = (bf16)(x.z >> 16); VT[(e0 + 6) * LDS64 + s] = (bf16)(x.w & 0xffff); VT[(e0 + 7) * LDS64 + s] = (bf16)(x.w >> 16); }
    __syncthreads();
    float bl[16]; { float run = 0.f;
#pragma unroll
        for (int i = 0; i < 16; ++i) { const float g_ = G[(t0 + i) * 128 + d]; kv[i] = 1.0f - __expf(g_); run += g_; bl[i] = run; } PART[part * 128 + d] = run; }
    __syncthreads();
    float offs = 0.f, blast = 0.f;
#pragma unroll
    for (int p = 0; p < 4; ++p) { const float pv = PART[p * 128 + d]; blast += pv; if (p < part) offs += pv; }
    if (part == 0) LAM[(size_t)item * 128 + d] = __expf(blast);
    unsigned khp[8];
#pragma unroll
    for (int i = 0; i < 16; i += 2) {
        float kh2[2];
#pragma unroll
        for (int j = 0; j < 2; ++j) { const float bt = offs + bl[i + j]; const float q = siluf_(bf2f(qv[i + j])), k = kv[i + j];
            const bf16 qt = f2bf(q * __expf(bt)); QT[(t0 + i + j) * LDQ + d] = qt; Q[(rowbase + t0 + i + j) * HW + col0 + d] = qt;
            KT[(t0 + i + j) * LDQ + d] = f2bf(k * __expf(-bt)); kh2[j] = k * __expf(blast - bt); }
        khp[i >> 1] = pk2(kh2[0], kh2[1]);
    }
    *(LAS v4u*)(KH + d * LDS64 + t0) = (v4u){khp[0], khp[1], khp[2], khp[3]}; *(LAS v4u*)(KH + d * LDS64 + t0 + 8) = (v4u){khp[4], khp[5], khp[6], khp[7]};
    __syncthreads();
    if (item + step < 1024) HG_LOAD(item + step);
    const int lr = lane & 15, lq = lane >> 4;
#pragma unroll
    for (int r = 0; r < 2; ++r) { const int id = w + 8 * r, ts = id >> 2, tt = id & 3; f32x4 a = {0.f, 0.f, 0.f, 0.f};
        if (ts <= tt) {
#pragma unroll
            for (int ks = 0; ks < 4; ++ks) { const bf16x8 fa = *(const LAS bf16x8*)(KT + (ts * 16 + lr) * LDQ + ks * 32 + 8 * lq), fb = *(const LAS bf16x8*)(QT + (tt * 16 + lr) * LDQ + ks * 32 + 8 * lq);
                a = __builtin_amdgcn_mfma_f32_16x16x32_bf16(fa, fb, a, 0, 0, 0); } }
        const int t = tt * 16 + lr, s0 = ts * 16 + lq * 4;
        const float m0 = (s0 + 0 <= t) ? a[0] : 0.f, m1 = (s0 + 1 <= t) ? a[1] : 0.f, m2 = (s0 + 2 <= t) ? a[2] : 0.f, m3 = (s0 + 3 <= t) ? a[3] : 0.f;
        *(LAS v2u*)(AT + t * LDS64 + s0) = (v2u){pk2(m0, m1), pk2(m2, m3)}; }
    __syncthreads();
    const bf16x8 vf0 = *(const LAS bf16x8*)(VT + (w * 16 + lr) * LDS64 + 8 * lq), vf1 = *(const LAS bf16x8*)(VT + (w * 16 + lr) * LDS64 + 32 + 8 * lq);
#pragma unroll
    for (int tt = 0; tt < 4; ++tt) { f32x4 a = {0.f, 0.f, 0.f, 0.f};
        const bf16x8 f0 = *(const LAS bf16x8*)(AT + (tt * 16 + lr) * LDS64 + 8 * lq), f1 = *(const LAS bf16x8*)(AT + (tt * 16 + lr) * LDS64 + 32 + 8 * lq);
        a = __builtin_amdgcn_mfma_f32_16x16x32_bf16(vf0, f0, a, 0, 0, 0); a = __builtin_amdgcn_mfma_f32_16x16x32_bf16(vf1, f1, a, 0, 0, 0);
        *(v2u*)(INTRA + (rowbase + tt * 16 + lr) * HW + col0 + w * 16 + lq * 4) = (v2u){pk2(a[0], a[1]), pk2(a[2], a[3])}; }
    bf16* uo = UCT + (size_t)item * 16384 + (w * 16 + lr) * 128 + lq * 4;
#pragma unroll
    for (int dt = 0; dt < 8; ++dt) { f32x4 a = {0.f, 0.f, 0.f, 0.f};
        const bf16x8 f0 = *(const LAS bf16x8*)(KH + (dt * 16 + lr) * LDS64 + 8 * lq), f1 = *(const LAS bf16x8*)(KH + (dt * 16 + lr) * LDS64 + 32 + 8 * lq);
        a = __builtin_amdgcn_mfma_f32_16x16x32_bf16(f0, vf0, a, 0, 0, 0); a = __builtin_amdgcn_mfma_f32_16x16x32_bf16(f1, vf1, a, 0, 0, 0);
        *(v2u*)(uo + dt * 16) = (v2u){pk2(a[0], a[1]), pk2(a[2], a[3])}; }
    __syncthreads();
    }
#undef HG_LOAD
}
__device__ __forceinline__ void hgrn_scan(bf16* UCT, const float* LAM, int gtid, int gthreads) {
    for (int i = gtid; i < 32 * 128 * 32; i += gthreads) {
        const int bh = i >> 12, e = (i >> 5) & 127, d0 = (i & 31) * 4;
        bf16* p = UCT + (size_t)bh * 32 * 16384 + e * 128 + d0; const float* lp = LAM + (size_t)bh * 32 * 128 + d0;
        f32x4 S = {0.f, 0.f, 0.f, 0.f};
#pragma unroll 8
        for (int c = 0; c < 32; ++c) {
            const v2u uu = *(const v2u*)(p + (size_t)c * 16384); const f32x4 lam = *(const f32x4*)(lp + c * 128);
            *(v2u*)(p + (size_t)c * 16384) = (v2u){pk2(S[0], S[1]), pk2(S[2], S[3])};
            S = lam * S + (f32x4){bflo(uu.x), bfhi(uu.x), bflo(uu.y), bfhi(uu.y)};
        }
    }
}
__device__ __forceinline__ void hgrn_out_phase(int first, int step, int wave, int lane, const bf16* Qt, const bf16* SP, const bf16* INTRA, const bf16* Gs, const float* hn, bf16* OA) {
    const int wl = wave & 3, lr = lane & 15, lq = lane >> 4;
    f32x4 hn8[8];
#pragma unroll
    for (int et = 0; et < 8; ++et) hn8[et] = *(const f32x4*)(hn + et * 16 + lq * 4);
    bf16x8 bq[4]; v2u in8[8]; v2u gg8[8], ggn[8];
#define HO_ROW(PI) ((size_t)(((PI) * 2 + (wave >> 2)) >> 8) * SEQ + (((PI) * 2 + (wave >> 2)) & 31) * 64 + wl * 16 + lr)
#define HO_COL(PI) (((((PI) * 2 + (wave >> 2)) >> 5) & 7) * 128)
#define HO_LOAD_A(PI) do { const size_t r_ = HO_ROW(PI); const int c_ = HO_COL(PI); \
        _Pragma("unroll") for (int ks = 0; ks < 4; ++ks) bq[ks] = *(const bf16x8*)(Qt + r_ * HW + c_ + ks * 32 + 8 * lq); \
        _Pragma("unroll") for (int et = 0; et < 8; ++et) in8[et] = *(const v2u*)(INTRA + r_ * HW + c_ + et * 16 + lq * 4); } while (0)
#define HO_LOAD_G(DST, PI) do { const size_t r_ = HO_ROW(PI); const int c_ = HO_COL(PI); \
        _Pragma("unroll") for (int et = 0; et < 8; ++et) DST[et] = *(const v2u*)(Gs + r_ * HW + c_ + et * 16 + lq * 4); } while (0)
    if (first < 512) { HO_LOAD_A(first); HO_LOAD_G(gg8, first); }
    for (int pi = first; pi < 512; pi += step) {
        const int item = pi * 2 + (wave >> 2);
        const size_t row = HO_ROW(pi); const int col0 = HO_COL(pi);
        const bf16* sp = SP + (size_t)item * 16384 + lr * 128 + 8 * lq;
        f32x4 o[8]; float ss = 0.f;
#pragma unroll
        for (int et = 0; et < 8; ++et) { f32x4 a = (f32x4){bflo(in8[et].x), bfhi(in8[et].x), bflo(in8[et].y), bfhi(in8[et].y)};
#pragma unroll
            for (int ks = 0; ks < 4; ++ks) { const bf16x8 fa = *(const bf16x8*)(sp + et * 2048 + ks * 32); a = __builtin_amdgcn_mfma_f32_16x16x32_bf16(fa, bq[ks], a, 0, 0, 0); }
            o[et] = a; ss += (a[0] * a[0] + a[1] * a[1]) + (a[2] * a[2] + a[3] * a[3]); }
        const bool more = pi + step < 512;
        if (more) { HO_LOAD_A(pi + step); HO_LOAD_G(ggn, pi + step); }
        ss += __shfl_xor(ss, 16); ss += __shfl_xor(ss, 32);
        const float rn = rsqrtf(ss * (1.0f / 128.0f) + EPS);
#pragma unroll
        for (int et = 0; et < 8; ++et) { const int e0 = et * 16 + lq * 4; const f32x4 g4 = hn8[et]; const v2u gg = gg8[et];
            const float r0 = o[et][0] * rn * g4[0] * siluf_(bflo(gg.x)), r1 = o[et][1] * rn * g4[1] * siluf_(bfhi(gg.x)), r2 = o[et][2] * rn * g4[2] * siluf_(bflo(gg.y)), r3 = o[et][3] * rn * g4[3] * siluf_(bfhi(gg.y));
            *(v2u*)(OA + row * HW + col0 + e0) = (v2u){pk2(r0, r1), pk2(r2, r3)}; }
#pragma unroll
        for (int et = 0; et < 8; ++et) gg8[et] = ggn[et];
    }
#undef HO_ROW
#undef HO_COL
#undef HO_LOAD_A
#undef HO_LOAD_G
}

constexpr int S_W = 0, S_VN = 34816, S_ST = 69632;
__device__ __forceinline__ void gmlp_phase(int first, int step, LAS unsigned char* lds, const bf16* GV, const bf16* U, const float* stats, const float* lng, const float* lnb, const float* wsp, const float* bsp, bf16* UB, int tid) {
    const int lane = tid & 63, w = tid >> 6, lr = lane & 15, lq = lane >> 4;
    LAS bf16* WS = (LAS bf16*)(lds + S_W); LAS bf16* VN = (LAS bf16*)(lds + S_VN); LAS float* ST = (LAS float*)(lds + S_ST);
    v4u gvr[4]; float smr = 0.f, sqr = 0.f; int hs = -1;
#define GM_LOAD(IT) do { const int h_ = (IT) & 7, g_ = ((IT) >> 3) & 15, b_ = (IT) >> 7; const size_t rb_ = (size_t)b_ * SEQ + g_ * 128; \
        _Pragma("unroll") for (int i = 0; i < 4; ++i) { const int idx = i * 512 + tid, s_ = idx & 127, c0_ = (idx >> 7) * 8; gvr[i] = *(const v4u*)(GV + (rb_ + s_) * HW + h_ * 128 + c0_); } \
        if (tid < 128) { smr = stats[2 * (rb_ + tid)]; sqr = stats[2 * (rb_ + tid) + 1]; } } while (0)
    if (first < 512) GM_LOAD(first);
    for (int item = first; item < 512; item += step) {
        const int h = item & 7, g = (item >> 3) & 15, b = item >> 7;
        const size_t rowbase = (size_t)b * SEQ + g * 128; const int col0 = h * 128;
        if (tid < 128) { const float mu = smr * (1.0f / HW), var = sqr * (1.0f / HW) - mu * mu; ST[2 * tid] = mu; ST[2 * tid + 1] = rsqrtf(var + EPS); }
        if (h != hs) { hs = h;
#pragma unroll
            for (int i = 0; i < 8; ++i) { const int idx = i * 512 + tid, t = idx >> 5, s4 = (idx & 31) * 4; f32x4 x = *(const f32x4*)(wsp + ((size_t)h * 128 + t) * 128 + s4);
                if (t < 64 && s4 >= 64) x = (f32x4){0.f, 0.f, 0.f, 0.f};
                *(LAS v2u*)(WS + t * LDQ + s4) = (v2u){pk2(x[0], x[1]), pk2(x[2], x[3])}; } }
        v2u uu8[8]; float bs8[8];
#pragma unroll
        for (int tt = 0; tt < 8; ++tt) { uu8[tt] = *(const v2u*)(U + (rowbase + tt * 16 + lr) * HW + col0 + w * 16 + lq * 4); bs8[tt] = bsp[h * 128 + tt * 16 + lr]; }
        __syncthreads();
#pragma unroll
        for (int i = 0; i < 4; ++i) { const int idx = i * 512 + tid, s = idx & 127, c0 = (idx >> 7) * 8;
            const v4u x = gvr[i]; const float mu = ST[2 * s], rs = ST[2 * s + 1];
            const f32x4 g0 = *(const f32x4*)(lng + col0 + c0), g1 = *(const f32x4*)(lng + col0 + c0 + 4), b0 = *(const f32x4*)(lnb + col0 + c0), b1 = *(const f32x4*)(lnb + col0 + c0 + 4);
            VN[(c0 + 0) * LDQ + s] = f2bf((bflo(x.x) - mu) * rs * g0[0] + b0[0]); VN[(c0 + 1) * LDQ + s] = f2bf((bfhi(x.x) - mu) * rs * g0[1] + b0[1]);
            VN[(c0 + 2) * LDQ + s] = f2bf((bflo(x.y) - mu) * rs * g0[2] + b0[2]); VN[(c0 + 3) * LDQ + s] = f2bf((bfhi(x.y) - mu) * rs * g0[3] + b0[3]);
            VN[(c0 + 4) * LDQ + s] = f2bf((bflo(x.z) - mu) * rs * g1[0] + b1[0]); VN[(c0 + 5) * LDQ + s] = f2bf((bfhi(x.z) - mu) * rs * g1[1] + b1[1]);
            VN[(c0 + 6) * LDQ + s] = f2bf((bflo(x.w) - mu) * rs * g1[2] + b1[2]); VN[(c0 + 7) * LDQ + s] = f2bf((bfhi(x.w) - mu) * rs * g1[3] + b1[3]); }
        __syncthreads();
        if (item + step < 512) GM_LOAD(item + step);
        bf16x8 fa[4];
#pragma unroll
        for (int ks = 0; ks < 4; ++ks) fa[ks] = *(const LAS bf16x8*)(VN + (w * 16 + lr) * LDQ + ks * 32 + 8 * lq);
#pragma unroll
        for (int tt = 0; tt < 8; ++tt) { f32x4 a = {0.f, 0.f, 0.f, 0.f};
#pragma unroll
            for (int ks = 0; ks < 4; ++ks) { if (tt < 4 && ks >= 2) continue; const bf16x8 fb = *(const LAS bf16x8*)(WS + (tt * 16 + lr) * LDQ + ks * 32 + 8 * lq); a = __builtin_amdgcn_mfma_f32_16x16x32_bf16(fa[ks], fb, a, 0, 0, 0); }
            const int t = tt * 16 + lr, c0 = w * 16 + lq * 4; const float bs = bs8[tt];
            const size_t o = (rowbase + t) * HW + col0 + c0; const v2u uu = uu8[tt];
            const f32x2 u01 = gelu_pk((f32x2){bflo(uu.x), bfhi(uu.x)}), u23 = gelu_pk((f32x2){bflo(uu.y), bfhi(uu.y)});
            *(v2u*)(UB + o) = (v2u){pk2(u01.x * (a[0] + bs), u01.y * (a[1] + bs)), pk2(u23.x * (a[2] + bs), u23.y * (a[3] + bs))}; }
        __syncthreads();
    }
#undef GM_LOAD
}

#define RLX_AGENT __ATOMIC_RELAXED, __HIP_MEMORY_SCOPE_AGENT
#define XB_TMO      128
#define XB_XCNT(j)  (256  + 64 * (j))
#define XB_XSUB(j)  (1280 + 64 * (j))
#define XB_XGEN(j)  (2304 + 64 * (j))
#define XB_TOP      3328
#define XB_TOPGEN   3392
#define XCD_BAR_WORDS 3456
#define XB_SPIN_CAP (1u << 18)

__device__ __forceinline__ unsigned xb_ld(unsigned* p)              { return __hip_atomic_load(p, __ATOMIC_RELAXED, __HIP_MEMORY_SCOPE_AGENT); }
__device__ __forceinline__ unsigned xb_add(unsigned* p, unsigned v) { return __hip_atomic_fetch_add(p, v, __ATOMIC_RELAXED, __HIP_MEMORY_SCOPE_AGENT); }
__device__ __forceinline__ unsigned xb_xcc_id() { return (unsigned)__builtin_amdgcn_s_getreg((3 << 11) | 20) & 0xFu; }
#define XB_SPIN(cond, bar) do { unsigned _sp = 0; while (cond) { __builtin_amdgcn_s_sleep(1); \
    if ((++_sp & 255u) == 0u) { if (xb_ld(&(bar)[XB_TMO])) break; if (_sp > XB_SPIN_CAP) { atomicAdd(&(bar)[XB_TMO], 1u); break; } } } } while (0)

struct XcdBarrier {
    unsigned* bar; unsigned x;
    volatile LAS unsigned* st;
};

__device__ __forceinline__ XcdBarrier xcd_barrier_post(unsigned* bar, volatile LAS unsigned* st) {
    XcdBarrier b; b.bar = bar; b.x = xb_xcc_id(); b.st = st;
    if (threadIdx.x == 0) st[2] = xb_add(&bar[XB_XCNT(b.x)], 1u);
    return b;
}
__device__ __forceinline__ void xcd_barrier_complete(unsigned* bar, unsigned x, unsigned& nloc, unsigned& nx) {
    const unsigned G = gridDim.x * gridDim.y * gridDim.z;
    unsigned sum, cnt, mine, sp = 0u;
    for (;;) {
        sum = 0u; cnt = 0u; mine = 0u;
#pragma unroll
        for (unsigned j = 0; j < 16; ++j) { const unsigned c = xb_ld(&bar[XB_XCNT(j)]); sum += c; cnt += (c > 0u) ? 1u : 0u; mine = (j == x) ? c : mine; }
        if (sum == G) break;
        __builtin_amdgcn_s_sleep(1);
        if ((++sp & 255u) == 0u) { if (xb_ld(&bar[XB_TMO])) break; if (sp > XB_SPIN_CAP) { atomicAdd(&bar[XB_TMO], 1u); break; } }
    }
    nloc = mine > 0u ? mine : 1u; nx = cnt > 0u ? cnt : 1u;
}

__device__ __forceinline__ void xcd_barrier(const XcdBarrier& b) {
    asm volatile("s_waitcnt vmcnt(0)" ::: "memory");
    __syncthreads();
    if (threadIdx.x == 0) {
        unsigned* bar = b.bar;
        __builtin_amdgcn_s_waitcnt(0);
        unsigned nloc = b.st[0], nx = b.st[1];
        if (nloc == 0u) { xcd_barrier_complete(bar, b.x, nloc, nx); b.st[0] = nloc; b.st[1] = nx; }
        const unsigned old = xb_add(&bar[XB_XSUB(b.x)], 1u);
        const unsigned gen = old / nloc;
        if (old + 1u == (gen + 1u) * nloc) {
            __builtin_amdgcn_fence(__ATOMIC_RELEASE, "agent");
            asm volatile("s_waitcnt vmcnt(0)" ::: "memory");
            const unsigned og = xb_add(&bar[XB_TOP], 1u);
            const unsigned tg = og / nx;
            if (og + 1u == (tg + 1u) * nx) xb_add(&bar[XB_TOPGEN], 1u);
            else XB_SPIN(xb_ld(&bar[XB_TOPGEN]) == tg, bar);
            __builtin_amdgcn_fence(__ATOMIC_ACQUIRE, "agent");
            xb_add(&bar[XB_XGEN(b.x)], 1u);
            asm volatile("s_waitcnt vmcnt(0)" ::: "memory");
        } else {
            XB_SPIN(xb_ld(&bar[XB_XGEN(b.x)]) == gen, bar);
            __builtin_amdgcn_fence(__ATOMIC_ACQUIRE, "agent");
            asm volatile("s_waitcnt vmcnt(0)" ::: "memory");
        }
    }
    __syncthreads();
}

struct Args { const float* in[20]; float* out; unsigned char* ws; int ph_lo, ph_hi; };
constexpr int NPH = 10;
__global__ void __launch_bounds__(512, 2) fwd_kernel(Args args) {
    extern __shared__ __attribute__((aligned(16))) unsigned char lds_raw[];
    LAS unsigned char* lds = (LAS unsigned char*)lds_raw;
    const int tid = threadIdx.x, lane = tid & 63, wave = __builtin_amdgcn_readfirstlane(tid >> 6);
    const int G = gridDim.x, bid = blockIdx.x, gw = bid * 8 + wave, ngw = G * 8;
    unsigned char* ws = args.ws;
    const float* x = args.in[0]; const float* p = args.in[1]; const float* norm_mix = args.in[2]; const float* w_in = args.in[3]; const float* lb_logits = args.in[4];
    const float* hgrn_norm = args.in[5]; const float* w_a_out = args.in[6]; const float* ln_g = args.in[7]; const float* ln_b = args.in[8]; const float* w_spatial = args.in[9];
    const float* b_spatial = args.in[10]; const float* w_b_out = args.in[11]; const float* w_o = args.in[12]; const float* norm_ffn = args.in[13]; const float* w_ff1 = args.in[14];
    const float* w_ff2 = args.in[15]; const float* norm_ple = args.in[16]; const float* w_ple_gate = args.in[17]; const float* w_ple_proj = args.in[18]; const float* norm_final = args.in[19];
    float* out = args.out;
    bf16* SEG16 = (bf16*)(ws + WS_SEG16); float* LOGF = (float*)(ws + WS_LOGF); bf16* HID = (bf16*)(ws + WS_HID); bf16* GATE = (bf16*)(ws + WS_GATE); float* X1 = (float*)(ws + WS_X1);
    bf16* WIN = (bf16*)(ws + WS_WIN); bf16* XB = (bf16*)(ws + WS_XB); bf16* UCT = (bf16*)(ws + WS_UCT); bf16* OA = (bf16*)(ws + WS_OA); bf16* UBUF = (bf16*)(ws + WS_UB);
    bf16* MERGED = (bf16*)(ws + WS_MERGED); bf16* X1B = (bf16*)(ws + WS_X1B); bf16* W2T = (bf16*)(ws + WS_W2T); bf16* X2B = (bf16*)(ws + WS_X2B);
    bf16* WA = (bf16*)(ws + WS_WA); bf16* WB = (bf16*)(ws + WS_WB); bf16* WO = (bf16*)(ws + WS_WO); bf16* WG = (bf16*)(ws + WS_WG); bf16* WP = (bf16*)(ws + WS_WP); bf16* PB = (bf16*)(ws + WS_PB);
    bf16* INTRA = (bf16*)(ws + WS_INTRA); bf16* W1T = (bf16*)(ws + WS_W1T);
    float* R0 = (float*)(ws + WS_R0); float* STATS = (float*)(ws + WS_STATS); float* SS1 = (float*)(ws + WS_SS1); float* SS2 = (float*)(ws + WS_SS2); float* SS3 = (float*)(ws + WS_SS3);
    float* LB = (float*)(ws + WS_LB); float* LAM = (float*)(ws + WS_LAM);
    bf16* Qb = SEG16; bf16* Kb = SEG16 + (size_t)1 * MTOK * HW; bf16* Vb = SEG16 + (size_t)2 * MTOK * HW; bf16* Gb = SEG16 + (size_t)3 * MTOK * HW; bf16* Ub = SEG16 + (size_t)4 * MTOK * HW; bf16* GVb = SEG16 + (size_t)5 * MTOK * HW;
    bf16* GA = GATE; bf16* GBt = GATE + (size_t)MTOK * DM;

    const int lo = args.ph_lo, hi = args.ph_hi;
    volatile LAS unsigned* bst = (volatile LAS unsigned*)(lds + LDS_BYTES - 64);
    if (tid < 4) bst[tid] = 0u;
    __syncthreads();
    const XcdBarrier xbar = xcd_barrier_post((unsigned*)(ws + WS_BAR), bst);
#ifdef DBG_K
    for (size_t i = (size_t)bid * 512 + tid; i < (size_t)MTOK * DM; i += (size_t)G * 512) out[i] = 1.0f;
#endif
#define IN(k) (lo <= (k) && (k) < hi)
#define SEAM(k) do { if (IN(k) && IN((k) + 1)) { xcd_barrier(xbar); } } while (0)
#define GEMM(EpiT, E, Aop, Bop, Nn, Kk) do { pg8::Gemm g_{(const pg8::bf16_t*)(Aop), (const pg8::bf16_t*)(Bop), MTOK, (Nn), (Kk)}; pg8::StaticOrder S_; S_.init(MTOK, (Nn), G, vb); \
        pg8::gemm_phase<EpiT, pg8::StaticOrder, true, true>(lds, g_, S_, (E)); } while (0)

    if (IN(0)) {
        convert_weight(w_in, DM, NIN, WIN, norm_mix, lds, gw, ngw, wave, lane);
        convert_weight(w_a_out, HW, DM, WA, nullptr, lds, (gw + ngw - (ngw >> 1)) % ngw, ngw, wave, lane);
        convert_weight(w_b_out, HW, DM, WB, nullptr, lds, (gw + ngw - (ngw >> 1) - (ngw >> 3)) % ngw, ngw, wave, lane);
        convert_weight(w_o, DM, DM, WO, nullptr, lds, (gw + ngw - (ngw >> 1) - (ngw >> 2)) % ngw, ngw, wave, lane);
        { f32x4 xv[8], xw[8];
            if (gw < MTOK) { const f32x4* xr = (const f32x4*)(x + (size_t)gw * DM) + lane;
#pragma unroll
                for (int j = 0; j < 8; ++j) xv[j] = __builtin_nontemporal_load(xr + 64 * j); }
            for (int m = gw; m < MTOK; m += ngw) {
                if (m + ngw < MTOK) { const f32x4* xr = (const f32x4*)(x + (size_t)(m + ngw) * DM) + lane;
#pragma unroll
                    for (int j = 0; j < 8; ++j) xw[j] = __builtin_nontemporal_load(xr + 64 * j); }
                unsigned long long* o8 = (unsigned long long*)(XB + (size_t)m * DM) + lane; float sq = 0.f;
#pragma unroll
                for (int j = 0; j < 8; ++j) { const f32x4 v = xv[j]; sq += (v[0] * v[0] + v[1] * v[1]) + (v[2] * v[2] + v[3] * v[3]); o8[64 * j] = (unsigned long long)pk2(v[0], v[1]) | ((unsigned long long)pk2(v[2], v[3]) << 32); }
                sq = wave_sum(sq); if (lane == 0) R0[m] = rsqrtf(sq * (1.0f / DM) + EPS);
#pragma unroll
                for (int j = 0; j < 8; ++j) xv[j] = xw[j];
            } }
        for (int i = bid * 512 + tid; i < 40960; i += G * 512) STATS[i] = 0.f;
        for (int i = bid * 512 + tid; i < HW; i += G * 512) { const float l0 = lb_logits[i], l1 = lb_logits[HW + i], mx = fmaxf(l0, l1), e0 = expf(l0 - mx), e1 = expf(l1 - mx); LB[i] = e0 / (e0 + e1); }
    }
    SEAM(0);
    int vb = bid;
    if (IN(0) && IN(1)) {
        if (tid == 0) { unsigned* bar_ = (unsigned*)(ws + WS_BAR); bool ok = (G == 256);
            for (unsigned j = 0; j < 16; ++j) { const unsigned c_ = xb_ld(&bar_[XB_XCNT(j)]); ok = ok && (c_ == (j < 8 ? 32u : 0u)); }
            bst[3] = (ok && xbar.x < 8u && bst[2] < 32u) ? (bst[2] * 8u + xbar.x) : (unsigned)bid; }
        __syncthreads();
        vb = (int)bst[3];
    }
    if (IN(1)) { epi::EpiIn E{R0, LB, SEG16, GATE, LOGF, STATS}; GEMM(epi::EpiIn, E, XB, WIN, NIN, DM); }
    SEAM(1);
    if (IN(2)) { hgrn_local_phase(bid, G, lds, Qb, Kb, Vb, LOGF, INTRA, UCT, LAM, tid); }
    SEAM(2);
    if (IN(3)) { hgrn_scan(UCT, LAM, bid * 512 + tid, G * 512);
        gmlp_phase(bid, G, lds, GVb, Ub, STATS, ln_g, ln_b, w_spatial, b_spatial, UBUF, tid); }
    SEAM(3);
    if (IN(4)) { hgrn_out_phase(bid, G, wave, lane, Qb, UCT, INTRA, Gb, hgrn_norm, OA); }
    SEAM(4);
    if (IN(5)) {
        convert_weight(w_ff1, DM, DFF, W1T, norm_ffn, lds, gw, ngw, wave, lane); __syncthreads();
        { epi::EpiGateTmp E{GA, MERGED}; GEMM(epi::EpiGateTmp, E, OA, WA, DM, HW); }
        { epi::EpiMerge E{GBt, MERGED}; GEMM(epi::EpiMerge, E, UBUF, WB, DM, HW); }
    }
    SEAM(5);
    if (IN(6)) { epi::EpiRes<true> E{X1B, X1B, SS1}; GEMM(epi::EpiRes<true>, E, MERGED, WO, DM, DM); }
    SEAM(6);
    if (IN(7)) { convert_weight(w_ff2, DFF, DM, W2T, nullptr, lds, gw, ngw, wave, lane);
        convert_weight(w_ple_gate, DM, DM, WG, norm_ple, lds, gw, ngw, wave, lane);
        convert_weight(w_ple_proj, PLE, DM, WP, nullptr, lds, (gw + ngw - (ngw >> 1)) % ngw, ngw, wave, lane);
        for (int i = bid * 512 + tid; i < MTOK * PLE / 4; i += G * 512) { const f32x4 v = __builtin_nontemporal_load((const f32x4*)p + i); ((v2u*)PB)[i] = (v2u){pk2(v[0], v[1]), pk2(v[2], v[3])}; }
        __syncthreads();
        epi::EpiFF1 E{SS1, HID}; GEMM(epi::EpiFF1, E, X1B, W1T, DFF, DM); }
    SEAM(7);
    if (IN(8)) {
        { epi::EpiRes<true> E{X1B, X2B, SS2}; GEMM(epi::EpiRes<true>, E, HID, W2T, DM, DFF); }
        { epi::EpiGateTmp E{nullptr, (bf16*)(ws + WS_GATE)}; GEMM(epi::EpiGateTmp, E, PB, WP, DM, PLE); }
    }
    SEAM(8);
    if (IN(9)) {
        bf16* PPB = (bf16*)(ws + WS_GATE);
        { epi::EpiPleFinal E{X2B, SS2, PPB, out, SS3, norm_final, (unsigned*)(ws + WS_PCNT)}; GEMM(epi::EpiPleFinal, E, X2B, WG, DM, DM); }
    }
    if (lo < 0) cg::this_grid().sync();
#ifdef DBG_K
    if (hi == DBG_K + 1) {
        cg::this_grid().sync();
        const size_t N16 = (size_t)MTOK * DM;
        for (size_t i = (size_t)bid * 512 + tid; i < N16; i += (size_t)G * 512) {
            float v = 0.f; const size_t h = i & (N16 / 2 - 1);
            if (DBG_K == 0) v = bf2f(XB[i]) + R0[i & 8191] + bf2f(WIN[i]) + bf2f(WA[i & 2097151]) + bf2f(WB[i & 2097151]) + bf2f(WO[i & 4194303]) + LB[i & 1023];
            if (DBG_K == 1) v = bf2f(SEG16[i]) + bf2f(SEG16[i + N16]) + bf2f(SEG16[i + 2 * N16]) + bf2f(GATE[i]) + bf2f(GATE[i + N16]) + LOGF[h] + STATS[i & 16383];
            if (DBG_K == 2) v = bf2f(Qb[h]) + INTRA[h] + bf2f(UCT[i]) + LAM[i & 131071];
            if (DBG_K == 3) v = bf2f(UCT[i]) + bf2f(UBUF[h]);
            if (DBG_K == 4) v = bf2f(OA[h]);
            if (DBG_K == 5) v = bf2f(MERGED[i]);
            if (DBG_K == 7) v = bf2f(HID[i]) + bf2f(HID[i + N16]) + bf2f(HID[i + 2 * N16]) + bf2f(HID[i + 3 * N16]);
            out[i] = v;
        }
    }
#endif
#undef IN
#undef SEAM
#undef GEMM
}

#ifndef N_LAUNCHES
#define N_LAUNCHES 1
#endif
extern "C" void kernel_launch(void* const* d_in, const int* in_sizes, int n_in, void* d_out, int out_size, void* d_ws, size_t ws_size, hipStream_t stream) {
    static int grid = 0;
    if (grid == 0) {
        if (n_in != 20 || out_size != MTOK * DM || ws_size < WS_END) { fprintf(stderr, "kernel_launch: unexpected shapes (n_in %d, out %d, ws %zu)\n", n_in, out_size, ws_size); grid = -1; return; }
        int dev = 0, cus = 0, per_cu = 0;
        hipGetDevice(&dev); hipDeviceGetAttribute(&cus, hipDeviceAttributeMultiprocessorCount, dev);
        if (hipFuncSetAttribute((const void*)fwd_kernel, hipFuncAttributeMaxDynamicSharedMemorySize, LDS_BYTES) != hipSuccess) { fprintf(stderr, "kernel_launch: hipFuncSetAttribute failed\n"); grid = -1; return; }
        hipOccupancyMaxActiveBlocksPerMultiprocessor(&per_cu, (const void*)fwd_kernel, 512, LDS_BYTES);
        if (per_cu < 1) { fprintf(stderr, "kernel_launch: occupancy query says %d blocks per CU\n", per_cu); per_cu = 1; }
        (void)hipGetLastError();
        grid = cus;
    }
    if (grid < 0) return;
    Args a{};
    for (int i = 0; i < 20; ++i) a.in[i] = (const float*)d_in[i];
    a.out = (float*)d_out; a.ws = (unsigned char*)d_ws;
    if (hipMemsetAsync((char*)d_ws + WS_BAR, 0, WS_BAR_BYTES, stream) != hipSuccess) { fprintf(stderr, "kernel_launch: memset failed\n"); return; }
    if (N_LAUNCHES == 1) {
        a.ph_lo = 0; a.ph_hi = NPH;
#ifdef DBG_K
        a.ph_hi = DBG_K + 1;
#endif
        void* kargs[] = {&a};
        hipError_t e = hipLaunchCooperativeKernel((const void*)fwd_kernel, dim3(grid), dim3(512), kargs, LDS_BYTES, stream);
        if (e != hipSuccess) fprintf(stderr, "kernel_launch: cooperative launch failed: %s (grid %d)\n", hipGetErrorString(e), grid);
    } else {
        for (int ph = 0; ph < NPH; ++ph) { a.ph_lo = ph; a.ph_hi = ph + 1; hipLaunchKernelGGL(fwd_kernel, dim3(grid), dim3(512), LDS_BYTES, stream, a); }
    }
}
```
